# Optimizing an MI355X kernel written in HIP

```python
import math
import jax
import jax.numpy as jnp
from jax import lax
import numpy as np

D_MODEL = 2048
BATCH = 4
SEQ = 4096
DEPTH = 2

CTX_LEN = 256
GRID_W = 64
HEAD_DIM = 128
N_BRANCHES = 4
BRANCH_WIDTH = 4 * HEAD_DIM
GQA_HEADS = 4
GQA_KV_HEADS = 2
DIFF_HEADS = 4
DIFF_QK_DIM = 64
NA_HEADS = 4
NA_ROWS = 8
NA_COLS = 16
SWA_HEADS = 4
SWA_KV_HEADS = 2
SWA_WINDOW = 128
Q_BLOCK = 128
D_FF = 5632
N_EXPERTS = 8
TOP_K = 2
N_DENSE_LAYERS = (DEPTH + 1) // 2
N_MOE_LAYERS = DEPTH // 2
ADA_CHUNKS = 6
NORM_EPS = 1e-6
ROPE_THETA = 10000.0
NEG_INF = -1e30

IN_SPLITS = (
    GQA_HEADS * HEAD_DIM, GQA_KV_HEADS * HEAD_DIM, GQA_KV_HEADS * HEAD_DIM,
    DIFF_HEADS * 2 * DIFF_QK_DIM, DIFF_HEADS * 2 * DIFF_QK_DIM, DIFF_HEADS * HEAD_DIM,
    NA_HEADS * HEAD_DIM, NA_HEADS * HEAD_DIM, NA_HEADS * HEAD_DIM,
    SWA_HEADS * HEAD_DIM, SWA_KV_HEADS * HEAD_DIM, SWA_KV_HEADS * HEAD_DIM,
    N_BRANCHES * D_MODEL,
)
IN_COLS = sum(IN_SPLITS)

kernel_name = "hybrid_dit_parallel_mixers_moe"


def rms_norm(x, g):
    xf = x.astype(jnp.float32)
    y = xf * lax.rsqrt(jnp.mean(xf * xf, axis=-1, keepdims=True) + NORM_EPS)
    return (y * g.astype(jnp.float32)).astype(x.dtype)


def modulate(h, shift, scale):
    return h * (1 + scale) + shift


def rope_1d(x, pos):
    half = x.shape[-1] // 2
    freqs = ROPE_THETA ** (-jnp.arange(half, dtype=jnp.float32) / half)
    ang = pos[:, None] * freqs[None, :]
    cos = jnp.cos(ang).astype(x.dtype)
    sin = jnp.sin(ang).astype(x.dtype)
    x1, x2 = x[..., :half], x[..., half:]
    return jnp.concatenate([x1 * cos - x2 * sin, x1 * sin + x2 * cos], axis=-1)


def axial_rope(x, rows, cols):
    h = x.shape[-1] // 2
    return jnp.concatenate([rope_1d(x[..., :h], rows), rope_1d(x[..., h:], cols)], axis=-1)


def to_heads(t, n_heads):
    b, n, _ = t.shape
    return t.reshape(b, n, n_heads, -1).transpose(0, 2, 1, 3)


def from_heads(t):
    b, h, n, d = t.shape
    return t.transpose(0, 2, 1, 3).reshape(b, n, h * d)


def softmax_f32(s):
    return jax.nn.softmax(s.astype(jnp.float32), axis=-1)


def sink_softmax(s, sink):
    m = jnp.maximum(jnp.max(s, axis=-1, keepdims=True), sink)
    e = jnp.exp(s - m)
    return e / (jnp.sum(e, axis=-1, keepdims=True) + jnp.exp(sink - m))


def sweep_query_blocks(fn, q):
    n, d = q.shape[-2], q.shape[-1]
    nb = n // Q_BLOCK
    qb = jnp.moveaxis(q.reshape(q.shape[:-2] + (nb, Q_BLOCK, d)), -3, 0)
    out = jnp.moveaxis(lax.map(fn, qb), 0, -3)
    return out.reshape(out.shape[:-3] + (n, out.shape[-1]))


def gqa_attend(q, k, v):
    scale = q.shape[-1] ** -0.5

    def block(qb):
        s = jnp.einsum('bkgqd,bksd->bkgqs', qb, k).astype(jnp.float32) * scale
        return jnp.einsum('bkgqs,bksd->bkgqd', softmax_f32(s).astype(v.dtype), v)

    return sweep_query_blocks(block, q)


def mixer_gqa(q_l, k_l, v_l, q_c, k_c, v_c, qk_g, rows, cols, need_ctx):
    g = GQA_HEADS // GQA_KV_HEADS

    def prep(q, k, v):
        return (rms_norm(to_heads(q, GQA_HEADS), qk_g[0]),
                rms_norm(to_heads(k, GQA_KV_HEADS), qk_g[1]),
                to_heads(v, GQA_KV_HEADS))

    ql, kl, vl = prep(q_l, k_l, v_l)
    qc, kc, vc = prep(q_c, k_c, v_c)
    ql = axial_rope(ql, rows, cols)
    kl = axial_rope(kl, rows, cols)
    b, _, n, d = ql.shape
    kk = jnp.concatenate([kc, kl], axis=2)
    vv = jnp.concatenate([vc, vl], axis=2)
    o_l = gqa_attend(ql.reshape(b, GQA_KV_HEADS, g, n, d), kk, vv).reshape(b, GQA_HEADS, n, d)
    o_c = None
    if need_ctx:
        l = qc.shape[2]
        o_c = from_heads(gqa_attend(qc.reshape(b, GQA_KV_HEADS, g, l, d), kc, vc).reshape(b, GQA_HEADS, l, d))
    return from_heads(o_l), o_c


def mixer_diff(q_l, k_l, v_l, q_c, k_c, v_c, lam_p, subln_g, lambda_init, rows, cols, need_ctx):
    def maps(t):
        b, n, _ = t.shape
        return t.reshape(b, n, DIFF_HEADS, 2, DIFF_QK_DIM).transpose(0, 2, 3, 1, 4)

    lp = lam_p.astype(jnp.float32)
    lam = jnp.exp(jnp.sum(lp[0] * lp[1])) - jnp.exp(jnp.sum(lp[2] * lp[3])) + lambda_init
    scale = DIFF_QK_DIM ** -0.5
    ql = axial_rope(maps(q_l), rows, cols)
    kl = axial_rope(maps(k_l), rows, cols)
    vl = to_heads(v_l, DIFF_HEADS)
    qc, kc, vc = maps(q_c), maps(k_c), to_heads(v_c, DIFF_HEADS)

    def attend(q, k, v):
        def block(qb):
            p = softmax_f32(jnp.einsum('bhmqd,bhmsd->bhmqs', qb, k).astype(jnp.float32) * scale)
            a = p[:, :, 0] - lam * p[:, :, 1]
            return jnp.einsum('bhqs,bhsd->bhqd', a.astype(v.dtype), v)
        o = sweep_query_blocks(block, q)
        return from_heads(rms_norm(o, subln_g) * (1.0 - lambda_init))

    o_l = attend(ql, jnp.concatenate([kc, kl], axis=3), jnp.concatenate([vc, vl], axis=2))
    o_c = attend(qc, kc, vc) if need_ctx else None
    return o_l, o_c


def mixer_neighborhood(q_l, k_l, v_l, q_c, k_c, v_c, rpb, need_ctx):
    ql, kl, vl = to_heads(q_l, NA_HEADS), to_heads(k_l, NA_HEADS), to_heads(v_l, NA_HEADS)
    qc, kc, vc = to_heads(q_c, NA_HEADS), to_heads(k_c, NA_HEADS), to_heads(v_c, NA_HEADS)
    b, h, n, d = ql.shape
    l = kc.shape[2]
    rows_n = n // GRID_W
    kr = min(NA_ROWS, rows_n)
    scale = d ** -0.5
    kg = kl.reshape(b, h, rows_n, GRID_W, d)
    vg = vl.reshape(b, h, rows_n, GRID_W, d)
    col = jnp.arange(GRID_W)
    cstart = jnp.clip(col - NA_COLS // 2, 0, GRID_W - NA_COLS)
    in_win = (col[None, :] >= cstart[:, None]) & (col[None, :] < cstart[:, None] + NA_COLS)
    dj = jnp.clip(col[None, :] - col[:, None] + NA_COLS - 1, 0, 2 * NA_COLS - 2)
    mask = jnp.broadcast_to(in_win[:, None, :], (GRID_W, kr, GRID_W)).reshape(GRID_W, kr * GRID_W)

    def row_block(args):
        r, q_row = args
        rs = jnp.clip(r - kr // 2, 0, rows_n - kr)
        kb = lax.dynamic_slice_in_dim(kg, rs, kr, axis=2).reshape(b, h, kr * GRID_W, d)
        vb = lax.dynamic_slice_in_dim(vg, rs, kr, axis=2).reshape(b, h, kr * GRID_W, d)
        di = rs + jnp.arange(kr) - r + NA_ROWS - 1
        bias = rpb[:, di][:, :, dj]
        bias = bias.transpose(0, 2, 1, 3).reshape(h, GRID_W, kr * GRID_W).astype(jnp.float32)
        s_band = jnp.einsum('bhqd,bhsd->bhqs', q_row, kb).astype(jnp.float32) * scale + bias
        s_band = jnp.where(mask, s_band, NEG_INF)
        s_ctx = jnp.einsum('bhqd,bhsd->bhqs', q_row, kc).astype(jnp.float32) * scale
        p = softmax_f32(jnp.concatenate([s_ctx, s_band], axis=-1)).astype(vb.dtype)
        return (jnp.einsum('bhqs,bhsd->bhqd', p[..., :l], vc)
                + jnp.einsum('bhqs,bhsd->bhqd', p[..., l:], vb))

    q_rows = jnp.moveaxis(ql.reshape(b, h, rows_n, GRID_W, d), 2, 0)
    o = lax.map(row_block, (jnp.arange(rows_n), q_rows))
    o_l = jnp.moveaxis(o, 0, 2).reshape(b, h, n, d)
    o_c = from_heads(gqa_attend(qc[:, :, None], kc, vc)[:, :, 0]) if need_ctx else None
    return from_heads(o_l), o_c


def mixer_swa_sink(q_l, k_l, v_l, q_c, k_c, v_c, sink, rows, cols, need_ctx):
    g = SWA_HEADS // SWA_KV_HEADS
    w = SWA_WINDOW
    ql = axial_rope(to_heads(q_l, SWA_HEADS), rows, cols)
    kl = axial_rope(to_heads(k_l, SWA_KV_HEADS), rows, cols)
    vl = to_heads(v_l, SWA_KV_HEADS)
    qc, kc, vc = to_heads(q_c, SWA_HEADS), to_heads(k_c, SWA_KV_HEADS), to_heads(v_c, SWA_KV_HEADS)
    b, _, n, d = ql.shape
    l = kc.shape[2]
    nb = n // w
    scale = d ** -0.5
    sink_kg = sink.astype(jnp.float32).reshape(SWA_KV_HEADS, g)
    qb = ql.reshape(b, SWA_KV_HEADS, g, nb, w, d)

    def bands(t):
        tp = jnp.pad(t, ((0, 0), (0, 0), (w, w), (0, 0))).reshape(b, SWA_KV_HEADS, nb + 2, w, d)
        return jnp.concatenate([tp[:, :, :-2], tp[:, :, 1:-1], tp[:, :, 2:]], axis=-2)

    kw, vw = bands(kl), bands(vl)
    qpos = jnp.arange(n).reshape(nb, w)
    kpos = jnp.arange(nb)[:, None] * w - w + jnp.arange(3 * w)[None, :]
    valid = ((jnp.abs(qpos[:, :, None] - kpos[:, None, :]) <= w)
             & (kpos >= 0)[:, None, :] & (kpos < n)[:, None, :])
    s_band = jnp.einsum('bkgnqd,bknsd->bkgnqs', qb, kw).astype(jnp.float32) * scale
    s_band = jnp.where(valid, s_band, NEG_INF)
    s_ctx = jnp.einsum('bkgnqd,bksd->bkgnqs', qb, kc).astype(jnp.float32) * scale
    p = sink_softmax(jnp.concatenate([s_ctx, s_band], axis=-1),
                     sink_kg[None, :, :, None, None, None]).astype(vl.dtype)
    o = (jnp.einsum('bkgnqs,bksd->bkgnqd', p[..., :l], vc)
         + jnp.einsum('bkgnqs,bknsd->bkgnqd', p[..., l:], vw))
    o_l = from_heads(o.reshape(b, SWA_HEADS, n, d))
    o_c = None
    if need_ctx:
        s = jnp.einsum('bkgqd,bksd->bkgqs', qc.reshape(b, SWA_KV_HEADS, g, l, d), kc).astype(jnp.float32) * scale
        pc = sink_softmax(s, sink_kg[None, :, :, None, None]).astype(vc.dtype)
        o_c = from_heads(jnp.einsum('bkgqs,bksd->bkgqd', pc, vc).reshape(b, SWA_HEADS, l, d))
    return o_l, o_c


def merge_branches(outs, gate_logits, w_branch, w_out):
    o = jnp.stack(outs, axis=2)
    y = jnp.einsum('bnic,icm->bnim', o, w_branch)
    g = jax.nn.sigmoid(gate_logits.reshape(gate_logits.shape[:2] + (N_BRANCHES, D_MODEL)))
    return jnp.sum(g * y, axis=2) @ w_out


def token_mixers(h_lat, h_ctx, w_in, qk_g, lam_p, subln_g, rpb, sink, w_branch, w_out, lambda_init, need_ctx):
    n = h_lat.shape[1]
    pos = jnp.arange(n)
    rows = (pos // GRID_W).astype(jnp.float32)
    cols = (pos % GRID_W).astype(jnp.float32)
    points = [int(p) for p in np.cumsum(IN_SPLITS)[:-1]]
    pl = jnp.split(h_lat @ w_in, points, axis=-1)
    pc = jnp.split(h_ctx @ w_in, points, axis=-1)
    a_l, a_c = mixer_gqa(*pl[0:3], *pc[0:3], qk_g, rows, cols, need_ctx)
    b_l, b_c = mixer_diff(*pl[3:6], *pc[3:6], lam_p, subln_g, lambda_init, rows, cols, need_ctx)
    c_l, c_c = mixer_neighborhood(*pl[6:9], *pc[6:9], rpb, need_ctx)
    d_l, d_c = mixer_swa_sink(*pl[9:12], *pc[9:12], sink, rows, cols, need_ctx)
    y_lat = merge_branches([a_l, b_l, c_l, d_l], pl[12], w_branch, w_out)
    y_ctx = merge_branches([a_c, b_c, c_c, d_c], pc[12], w_branch, w_out) if need_ctx else None
    return y_lat, y_ctx


def swiglu(h, wg, wu, wd):
    return (jax.nn.silu(h @ wg) * (h @ wu)) @ wd


def moe_swiglu(h, router, wg, wu, wd):
    probs = jax.nn.softmax((h @ router).astype(jnp.float32), axis=-1)
    top_p, top_i = lax.top_k(probs, TOP_K)
    top_p = top_p / jnp.sum(top_p, axis=-1, keepdims=True)
    combine = jnp.sum(jax.nn.one_hot(top_i, N_EXPERTS, dtype=jnp.float32) * top_p[..., None], axis=-2).astype(h.dtype)
    y = jnp.zeros_like(h)
    for e in range(N_EXPERTS):
        y = y + combine[..., e:e + 1] * swiglu(h, wg[e], wu[e], wd[e])
    return y


def setup_inputs(seed: int = 0) -> dict:
    key = jax.random.key(seed)
    ks = jax.random.split(key, 24)
    f32 = jnp.float32

    def w(k, shape, fan_in, gain=1.0):
        return jax.random.normal(k, shape, f32) * (gain * fan_in ** -0.5)

    def near_one(k, shape):
        return 1.0 + 0.02 * jax.random.normal(k, shape, f32)

    return {
        "x": jax.random.normal(ks[0], (BATCH, SEQ, D_MODEL), f32),
        "c": jax.random.normal(ks[1], (BATCH, D_MODEL), f32),
        "ctx": jax.random.normal(ks[2], (BATCH, CTX_LEN, D_MODEL), f32),
        "c_ctx": jax.random.normal(ks[3], (D_MODEL,), f32),
        "attn_norm_g": near_one(ks[4], (DEPTH, D_MODEL)),
        "ffn_norm_g": near_one(ks[5], (DEPTH, D_MODEL)),
        "ada_w": w(ks[6], (DEPTH, D_MODEL, ADA_CHUNKS * D_MODEL), D_MODEL, 0.5),
        "ada_b": 0.02 * jax.random.normal(ks[7], (DEPTH, ADA_CHUNKS * D_MODEL), f32),
        "w_in": w(ks[8], (DEPTH, D_MODEL, IN_COLS), D_MODEL),
        "qk_norm_g": near_one(ks[9], (DEPTH, 2, HEAD_DIM)),
        "diff_lambda": 0.1 * jax.random.normal(ks[10], (DEPTH, 4, DIFF_QK_DIM), f32),
        "diff_subln_g": near_one(ks[11], (DEPTH, HEAD_DIM)),
        "na_rpb": 0.1 * jax.random.normal(ks[12], (DEPTH, NA_HEADS, 2 * NA_ROWS - 1, 2 * NA_COLS - 1), f32),
        "swa_sink": 0.5 * jax.random.normal(ks[13], (DEPTH, SWA_HEADS), f32),
        "w_branch": w(ks[14], (DEPTH, N_BRANCHES, BRANCH_WIDTH, D_MODEL), BRANCH_WIDTH),
        "w_out": w(ks[15], (DEPTH, D_MODEL, D_MODEL), D_MODEL),
        "ffn_w_gate": w(ks[16], (N_DENSE_LAYERS, D_MODEL, D_FF), D_MODEL),
        "ffn_w_up": w(ks[17], (N_DENSE_LAYERS, D_MODEL, D_FF), D_MODEL),
        "ffn_w_down": w(ks[18], (N_DENSE_LAYERS, D_FF, D_MODEL), D_FF),
        "moe_router": w(ks[19], (N_MOE_LAYERS, D_MODEL, N_EXPERTS), D_MODEL),
        "moe_w_gate": w(ks[20], (N_MOE_LAYERS, N_EXPERTS, D_MODEL, D_FF), D_MODEL),
        "moe_w_up": w(ks[21], (N_MOE_LAYERS, N_EXPERTS, D_MODEL, D_FF), D_MODEL),
        "moe_w_down": w(ks[22], (N_MOE_LAYERS, N_EXPERTS, D_FF, D_MODEL), D_FF),
        "final_norm_g": near_one(ks[23], (D_MODEL,)),
    }


def reference(x, c, ctx, c_ctx, attn_norm_g, ffn_norm_g, ada_w, ada_b, w_in, qk_norm_g,
              diff_lambda, diff_subln_g, na_rpb, swa_sink, w_branch, w_out,
              ffn_w_gate, ffn_w_up, ffn_w_down, moe_router, moe_w_gate, moe_w_up, moe_w_down,
              final_norm_g):
    x_lat, x_ctx = x, ctx
    l = ctx.shape[1]
    for i in range(DEPTH):
        need_ctx = i < DEPTH - 1
        sh_a, sc_a, g_a, sh_f, sc_f, g_f = [m[:, None, :] for m in jnp.split(jax.nn.silu(c) @ ada_w[i] + ada_b[i], ADA_CHUNKS, axis=-1)]
        csh_a, csc_a, cg_a, csh_f, csc_f, cg_f = jnp.split(jax.nn.silu(c_ctx) @ ada_w[i] + ada_b[i], ADA_CHUNKS, axis=-1)
        lambda_init = 0.8 - 0.6 * math.exp(-0.3 * i)
        h_lat = modulate(rms_norm(x_lat, attn_norm_g[i]), sh_a, sc_a)
        h_ctx = modulate(rms_norm(x_ctx, attn_norm_g[i]), csh_a, csc_a)
        y_lat, y_ctx = token_mixers(h_lat, h_ctx, w_in[i], qk_norm_g[i], diff_lambda[i], diff_subln_g[i],
                                    na_rpb[i], swa_sink[i], w_branch[i], w_out[i], lambda_init, need_ctx)
        x_lat = x_lat + g_a * y_lat
        h_lat = modulate(rms_norm(x_lat, ffn_norm_g[i]), sh_f, sc_f)
        if need_ctx:
            x_ctx = x_ctx + cg_a * y_ctx
            h_ctx = modulate(rms_norm(x_ctx, ffn_norm_g[i]), csh_f, csc_f)
            h = jnp.concatenate([h_ctx, h_lat], axis=1)
        else:
            h = h_lat
        j = i // 2
        if i % 2 == 0:
            f = swiglu(h, ffn_w_gate[j], ffn_w_up[j], ffn_w_down[j])
        else:
            f = moe_swiglu(h, moe_router[j], moe_w_gate[j], moe_w_up[j], moe_w_down[j])
        if need_ctx:
            x_ctx = x_ctx + cg_f * f[:, :l]
            x_lat = x_lat + g_f * f[:, l:]
        else:
            x_lat = x_lat + g_f * f
    return rms_norm(x_lat, final_norm_g)
```

```cpp
#include <hip/hip_runtime.h>
#include <cstdio>
#include <cstdint>

#ifndef MK_PER_PHASE
#define MK_PER_PHASE 1
#endif

#define LAS __attribute__((address_space(3)))
typedef unsigned short bf16_t;
typedef short bf16x8 __attribute__((ext_vector_type(8)));
typedef float f32x4 __attribute__((ext_vector_type(4)));
typedef float f32x2 __attribute__((ext_vector_type(2)));
typedef unsigned u32x4 __attribute__((ext_vector_type(4)));
typedef unsigned u32x2 __attribute__((ext_vector_type(2)));

constexpr int NWAVES = 8, NTHREADS = 512;
constexpr int D = 2048, NB = 4, SEQ = 4096, CTXL = 256, RPB = 4352, MROWS = 17408, NPAN = 68, PPB = 17;
constexpr int LDQ = 5120, LDG = 8192, INCOLS = 13312, DFF = 5632, NEXP = 8, ADA = 12288;
constexpr int MOE_MAXPAN = 135;
constexpr float NORM_EPS = 1e-6f;
constexpr int C_GQ = 0, C_GK = 512, C_GV = 768, C_DQ = 1024, C_DK = 1536, C_DV = 2048, C_NQ = 2560, C_NK = 3072, C_NV = 3584, C_SQ = 4096, C_SK = 4608, C_SV = 4864;

constexpr size_t MiB = 1u << 20;
constexpr size_t WS_CTL = 0, CTL_ZERO_BYTES = 2 * MiB;
constexpr size_t WS_MOD = 1 * MiB;
constexpr size_t WS_ROPE = 2 * MiB;
constexpr size_t WS_ROUTE = 3 * MiB;
constexpr size_t WS_WIN = 4 * MiB;
constexpr size_t WS_WBR = 108 * MiB;
constexpr size_t WS_WOUT = 124 * MiB;
constexpr size_t WS_WGU0 = 140 * MiB;
constexpr size_t WS_WD0 = 184 * MiB;
constexpr size_t WS_WGUM = 206 * MiB;
constexpr size_t WS_WDM = 558 * MiB;
constexpr size_t WS_H = 734 * MiB;
constexpr size_t WS_QKV = 802 * MiB;
constexpr size_t WS_GATES = 972 * MiB;
constexpr size_t WS_ACT = WS_QKV;
constexpr size_t WS_O = 1244 * MiB;
constexpr size_t WS_MERGED = 1312 * MiB;
constexpr size_t WS_XS = WS_O;
constexpr size_t WS_X1 = 1380 * MiB;
constexpr size_t WS_X2 = 1516 * MiB;
constexpr size_t WS_SCR = WS_X1;
constexpr size_t WS_Y2 = WS_X2;
constexpr size_t WS_END = 1652 * MiB;
constexpr int CW_TMO = 0, CW_BAR = 4096, CW_CNT = 8192, CW_CUR = 8256;

constexpr int RING_BYTES = 131072, LDS_BYTES = 147456, MISC_OFF = LDS_BYTES - 512;

__device__ __forceinline__ unsigned cvt_pk_bf16(float lo, float hi) { unsigned r; asm volatile("v_cvt_pk_bf16_f32 %0, %1, %2" : "=v"(r) : "v"(lo), "v"(hi)); return r; }
__device__ __forceinline__ float bflo(unsigned w) { return __uint_as_float(w << 16); }
__device__ __forceinline__ float bfhi(unsigned w) { return __uint_as_float(w & 0xffff0000u); }
__device__ __forceinline__ float bf2f(bf16_t h) { return __uint_as_float(((unsigned)h) << 16); }
__device__ __forceinline__ float wave_sum(float v) {
#pragma unroll
    for (int o = 1; o < 64; o <<= 1) v += __shfl_xor(v, o);
    return v;
}
__device__ __forceinline__ float wave_max(float v) {
#pragma unroll
    for (int o = 1; o < 64; o <<= 1) v = fmaxf(v, __shfl_xor(v, o));
    return v;
}
__device__ __forceinline__ float sigmoid_f(float x) { return __builtin_amdgcn_rcpf(1.0f + __builtin_amdgcn_exp2f(-1.4426950408889634f * x)); }
typedef long long modacc_t;
constexpr float MOD_SCALE = 1099511627776.0f, MOD_INV = 1.0f / 1099511627776.0f;
__device__ __forceinline__ f32x4 mod4(const modacc_t* p) { return (f32x4){(float)p[0] * MOD_INV, (float)p[1] * MOD_INV, (float)p[2] * MOD_INV, (float)p[3] * MOD_INV}; }
#define LDS_WAIT() asm volatile("s_waitcnt lgkmcnt(0)" ::: "memory")
#define VM_WAIT() asm volatile("s_waitcnt vmcnt(0)" ::: "memory")

namespace pg8 {
#define PG8_LAS __attribute__((address_space(3)))
constexpr int BM = 256, BK = 64, HALF = 128, HTB = HALF * BK * 2, STAGE_BYTES = 8 * HTB;
__host__ __device__ __forceinline__ int lds_byte(int r, int c) { const int st = (r >> 4) * 2 + (c >> 5), rr = r & 15, cc = c & 31, ob = rr * 64 + cc * 2; return st * 1024 + (ob ^ (((ob >> 9) & 1) << 5)); }
__host__ __device__ __forceinline__ void stage_rc(int b, int& R, int& C) { const int st = b / 1024, sb = b % 1024, swz = sb ^ (((sb >> 9) & 1) << 5); R = (st >> 1) * 16 + swz / 64; C = (st & 1) * 32 + (swz % 64) / 2; }
__host__ __device__ __forceinline__ int perm32(int rho) { const int n = rho >> 4, i = rho & 15; return 8 * (i >> 2) + 4 * n + (i & 3); }

struct Unit { int pm, pn, aux; const char* A; const char* B; };
struct Dims { int lda, ldb, K; };

__device__ __forceinline__ void tile_of(int L, int nM, int nN, int& pm, int& pn) {
    const int nwg = nM * nN; int wgid = L;
    { const int q = nwg / 8, r = nwg % 8, xcd = wgid % 8, off = wgid / 8; wgid = (xcd < r ? xcd * (q + 1) : r * (q + 1) + (xcd - r) * q) + off; }
    const int nig = 8 * nN, gid = wgid / nig, fm = gid * 8, gsz = (nM - fm) < 8 ? (nM - fm) : 8;
    pm = fm + ((wgid % nig) % gsz); pn = (wgid % nig) / gsz;
}

template <class Epi, class Sched, bool ALIGN_EPI = true, bool SP2 = true>
__device__ __forceinline__ void gemm_phase(PG8_LAS unsigned char* lds, const Dims g, const Sched& S, const Epi& E) {
    const int tid = threadIdx.x, wid = __builtin_amdgcn_readfirstlane(tid >> 6), lane = tid & 63, wr = wid >> 2, wc = wid & 3, fr = lane & 15, fq = lane >> 4;
    const int nt = g.K / BK;
    unsigned voffA[2], voffB[2];
#pragma unroll
    for (int i = 0; i < 2; ++i) { int R, C; stage_rc(tid * 16 + i * 8192, R, C); const int Rb = Epi::PERM ? ((R & ~31) + perm32(R & 31)) : R;
        voffA[i] = (unsigned)(R * g.lda + C) * 2u; voffB[i] = (unsigned)(Rb * g.ldb + C) * 2u; }
    const size_t kstep = (size_t)(BK * 2);
    const size_t hstepA = (size_t)HALF * g.lda * 2, hstepB = (size_t)HALF * g.ldb * 2;
    const unsigned ldsw = (unsigned)wid * 1024u;
    const int aoff = lds_byte(wr * 64 + fr, fq * 8), boff = lds_byte(wc * 32 + fr, fq * 8);
#define PG8_SA(b, h) (((b) * 2 + (h)) * HTB)
#define PG8_SB(b, h) ((4 + (b) * 2 + (h)) * HTB)
#define PG8_STAGE(bufoff, gbase, voff) do { _Pragma("unroll") for (int _i = 0; _i < 2; ++_i) \
        __builtin_amdgcn_global_load_lds((const unsigned*)((const char*)(gbase) + (voff)[_i]), (PG8_LAS unsigned*)(lds + (bufoff) + ldsw + _i * 8192), 16, 0, 0); } while (0)
#define PG8_LDA(dst, b, h) do { _Pragma("unroll") for (int m = 0; m < 4; ++m) _Pragma("unroll") for (int k = 0; k < 2; ++k) dst[m][k] = *(const PG8_LAS bf16x8*)(lds + PG8_SA(b, h) + aoff + m * 2048 + k * 1024); } while (0)
#define PG8_LDB(dst, b, h) do { _Pragma("unroll") for (int n = 0; n < 2; ++n) _Pragma("unroll") for (int k = 0; k < 2; ++k) dst[n][k] = *(const PG8_LAS bf16x8*)(lds + PG8_SB(b, h) + boff + n * 2048 + k * 1024); } while (0)
#define PG8_MMA(ai, bj, At, Bt) do { __builtin_amdgcn_s_setprio(1); _Pragma("unroll") for (int m = 0; m < 4; ++m) _Pragma("unroll") for (int n = 0; n < 2; ++n) _Pragma("unroll") for (int k = 0; k < 2; ++k) \
        acc[ai][bj][m][n] = __builtin_amdgcn_mfma_f32_16x16x32_bf16(Bt[n][k], At[m][k], acc[ai][bj][m][n], 0, 0, 0); __builtin_amdgcn_s_setprio(0); } while (0)
#define PG8_WAIT_V(n) asm volatile("s_waitcnt vmcnt(" #n ")" ::: "memory")
#define PG8_WAIT_L(n) asm volatile("s_waitcnt lgkmcnt(" #n ")" ::: "memory")
#define PG8_BAR __builtin_amdgcn_s_barrier()
#define PG8_SCHED __builtin_amdgcn_sched_barrier(0)
    Unit cur, nxt; int ui = 0;
    if (!S.next(0, cur)) return;
    f32x4 acc[2][2][4][2];
#pragma unroll
    for (int a = 0; a < 2; ++a)
#pragma unroll
        for (int b = 0; b < 2; ++b)
#pragma unroll
            for (int m = 0; m < 4; ++m)
#pragma unroll
                for (int n = 0; n < 2; ++n) acc[a][b][m][n] = (f32x4){0.f, 0.f, 0.f, 0.f};
    bf16x8 At[4][2], B0[2][2], B1[2][2];
    const char* cA = cur.A; const char* cB = cur.B;
    if constexpr (SP2) {
        PG8_STAGE(PG8_SB(0, 0), cB, voffB); PG8_STAGE(PG8_SB(0, 1), cB + hstepB, voffB); PG8_STAGE(PG8_SA(0, 0), cA, voffA); PG8_STAGE(PG8_SA(0, 1), cA + hstepA, voffA);
        if (wr == 1) PG8_BAR;
        PG8_WAIT_V(2); PG8_BAR;
        PG8_STAGE(PG8_SB(1, 0), cB + kstep, voffB); PG8_STAGE(PG8_SA(1, 0), cA + kstep, voffA); PG8_STAGE(PG8_SB(1, 1), cB + hstepB + kstep, voffB);
        PG8_WAIT_V(6); PG8_BAR;
    } else {
        PG8_STAGE(PG8_SB(0, 0), cB, voffB); PG8_STAGE(PG8_SA(0, 0), cA, voffA); PG8_STAGE(PG8_SB(0, 1), cB + hstepB, voffB); PG8_STAGE(PG8_SA(0, 1), cA + hstepA, voffA);
        if (wr == 1) PG8_BAR;
        PG8_WAIT_V(4); PG8_BAR;
        PG8_STAGE(PG8_SB(1, 0), cB + kstep, voffB); PG8_STAGE(PG8_SA(1, 0), cA + kstep, voffA); PG8_STAGE(PG8_SB(1, 1), cB + hstepB + kstep, voffB);
        PG8_WAIT_V(6); PG8_BAR;
    }
    for (;;) {
        const bool has_next = S.next(ui + 1, nxt);
        const char* nA = has_next ? nxt.A : cA; const char* nB = has_next ? nxt.B : cB;
        for (int t = 0; t < nt; t += 2) {
            const bool last = (t == nt - 2);
            const char* a1 = cA + (size_t)(t + 1) * kstep;
            const char* a2 = last ? nA : cA + (size_t)(t + 2) * kstep; const char* b2 = last ? nB : cB + (size_t)(t + 2) * kstep;
            const char* a3 = a2 + kstep; const char* b3 = b2 + kstep;
            if constexpr (SP2) {
            PG8_LDB(B0, 0, 0); PG8_LDB(B1, 0, 1); PG8_SCHED; PG8_LDA(At, 0, 0); PG8_STAGE(PG8_SA(1, 1), a1 + hstepA, voffA);
            PG8_WAIT_V(8); PG8_WAIT_L(0); PG8_BAR; PG8_MMA(0, 0, At, B0); PG8_MMA(0, 1, At, B1); PG8_BAR; PG8_SCHED;
            PG8_LDA(At, 0, 1); PG8_STAGE(PG8_SB(0, 0), b2, voffB); PG8_STAGE(PG8_SB(0, 1), b2 + hstepB, voffB); PG8_STAGE(PG8_SA(0, 0), a2, voffA);
            PG8_WAIT_V(8); PG8_WAIT_L(0); PG8_BAR; PG8_MMA(1, 0, At, B0); PG8_MMA(1, 1, At, B1); PG8_BAR; PG8_SCHED;
            PG8_LDB(B0, 1, 0); PG8_LDB(B1, 1, 1); PG8_SCHED; PG8_LDA(At, 1, 0); PG8_STAGE(PG8_SA(0, 1), a2 + hstepA, voffA);
            PG8_WAIT_V(8); PG8_WAIT_L(0); PG8_BAR; PG8_MMA(0, 0, At, B0); PG8_MMA(0, 1, At, B1); PG8_BAR; PG8_SCHED;
            PG8_LDA(At, 1, 1); PG8_STAGE(PG8_SB(1, 0), b3, voffB); PG8_STAGE(PG8_SB(1, 1), b3 + hstepB, voffB); PG8_STAGE(PG8_SA(1, 0), a3, voffA);
            PG8_WAIT_V(8); PG8_WAIT_L(0); PG8_BAR; PG8_MMA(1, 0, At, B0); PG8_MMA(1, 1, At, B1); PG8_BAR; PG8_SCHED;
            } else {
            PG8_LDB(B0, 0, 0); PG8_SCHED; PG8_LDA(At, 0, 0); PG8_STAGE(PG8_SA(1, 1), a1 + hstepA, voffA);
            PG8_WAIT_L(8); PG8_BAR; PG8_WAIT_L(0); PG8_MMA(0, 0, At, B0); PG8_BAR; PG8_SCHED;
            PG8_LDB(B1, 0, 1); PG8_STAGE(PG8_SB(0, 0), b2, voffB);
            PG8_BAR; PG8_WAIT_L(0); PG8_MMA(0, 1, At, B1); PG8_BAR;
            PG8_LDA(At, 0, 1); PG8_STAGE(PG8_SA(0, 0), a2, voffA);
            PG8_BAR; PG8_WAIT_L(0); PG8_MMA(1, 0, At, B0); PG8_BAR; PG8_SCHED;
            PG8_STAGE(PG8_SB(0, 1), b2 + hstepB, voffB);
            PG8_WAIT_V(6); PG8_BAR; PG8_MMA(1, 1, At, B1); PG8_BAR;
            PG8_LDB(B0, 1, 0); PG8_SCHED; PG8_LDA(At, 1, 0); PG8_STAGE(PG8_SA(0, 1), a2 + hstepA, voffA);
            PG8_WAIT_L(8); PG8_BAR; PG8_WAIT_L(0); PG8_MMA(0, 0, At, B0); PG8_BAR; PG8_SCHED;
            PG8_LDB(B1, 1, 1); PG8_STAGE(PG8_SB(1, 0), b3, voffB);
            PG8_BAR; PG8_WAIT_L(0); PG8_MMA(0, 1, At, B1); PG8_BAR;
            PG8_LDA(At, 1, 1); PG8_STAGE(PG8_SA(1, 0), a3, voffA);
            PG8_BAR; PG8_WAIT_L(0); PG8_MMA(1, 0, At, B0); PG8_BAR; PG8_SCHED;
            PG8_STAGE(PG8_SB(1, 1), b3 + hstepB, voffB);
            PG8_WAIT_V(6); PG8_BAR; PG8_MMA(1, 1, At, B1); PG8_BAR;
            }
        }
        if constexpr (ALIGN_EPI) { if (wr == 0) PG8_BAR; }
        E(acc, cur, wr, wc, fr, fq);
        if (!has_next) break;
#pragma unroll
        for (int a = 0; a < 2; ++a)
#pragma unroll
            for (int b = 0; b < 2; ++b)
#pragma unroll
                for (int m = 0; m < 4; ++m)
#pragma unroll
                    for (int n = 0; n < 2; ++n) acc[a][b][m][n] = (f32x4){0.f, 0.f, 0.f, 0.f};
        cur = nxt; cA = nA; cB = nB; ++ui;
        if constexpr (ALIGN_EPI) { if (wr == 1) PG8_BAR; }
    }
    PG8_WAIT_V(0);
    if constexpr (!ALIGN_EPI) { if (wr == 0) PG8_BAR; }
    PG8_BAR;
#undef PG8_SA
#undef PG8_SB
#undef PG8_STAGE
#undef PG8_LDA
#undef PG8_LDB
#undef PG8_MMA
#undef PG8_WAIT_V
#undef PG8_WAIT_L
#undef PG8_BAR
#undef PG8_SCHED
}
}

#define XB_TMO      128
#define XB_XCNT(j)  (256  + 64 * (j))
#define XB_XSUB(j)  (1280 + 64 * (j))
#define XB_XGEN(j)  (2304 + 64 * (j))
#define XB_TOP      3328
#define XB_TOPGEN   3392
#define XCD_BAR_WORDS 3456
#define XB_SPIN_CAP (1u << 18)
__device__ __forceinline__ unsigned xb_ld(unsigned* p)              { return __hip_atomic_load(p, __ATOMIC_RELAXED, __HIP_MEMORY_SCOPE_AGENT); }
__device__ __forceinline__ unsigned xb_add(unsigned* p, unsigned v) { return __hip_atomic_fetch_add(p, v, __ATOMIC_RELAXED, __HIP_MEMORY_SCOPE_AGENT); }
__device__ __forceinline__ unsigned xb_xcc_id() { return (unsigned)__builtin_amdgcn_s_getreg((3 << 11) | 20) & 0xFu; }
#define XB_SPIN(cond, bar) do { unsigned _sp = 0; while (cond) { __builtin_amdgcn_s_sleep(1); \
    if ((++_sp & 255u) == 0u) { if (xb_ld(&(bar)[XB_TMO])) break; if (_sp > XB_SPIN_CAP) { atomicAdd(&(bar)[XB_TMO], 1u); break; } } } } while (0)
struct XcdBarrier { unsigned* bar; unsigned x; volatile LAS unsigned* st; };
__device__ __forceinline__ XcdBarrier xcd_barrier_post(unsigned* bar, volatile LAS unsigned* st) {
    XcdBarrier b; b.bar = bar; b.x = xb_xcc_id(); b.st = st;
    if (threadIdx.x == 0) (void)xb_add(&bar[XB_XCNT(b.x)], 1u);
    return b;
}
__device__ __forceinline__ void xcd_barrier_complete(unsigned* bar, unsigned x, unsigned& nloc, unsigned& nx) {
    const unsigned G = gridDim.x * gridDim.y * gridDim.z;
    unsigned sum, cnt, mine, sp = 0u;
    for (;;) {
        sum = 0u; cnt = 0u; mine = 0u;
#pragma unroll
        for (unsigned j = 0; j < 16; ++j) { const unsigned c = xb_ld(&bar[XB_XCNT(j)]); sum += c; cnt += (c > 0u) ? 1u : 0u; mine = (j == x) ? c : mine; }
        if (sum == G) break;
        __builtin_amdgcn_s_sleep(1);
        if ((++sp & 255u) == 0u) { if (xb_ld(&bar[XB_TMO])) break; if (sp > XB_SPIN_CAP) { atomicAdd(&bar[XB_TMO], 1u); break; } }
    }
    nloc = mine > 0u ? mine : 1u; nx = cnt > 0u ? cnt : 1u;
}
__device__ __forceinline__ void xcd_barrier(const XcdBarrier& b) {
    asm volatile("s_waitcnt vmcnt(0)" ::: "memory");
    __syncthreads();
    if (threadIdx.x == 0) {
        unsigned* bar = b.bar;
        __builtin_amdgcn_s_waitcnt(0);
        unsigned nloc = b.st[0], nx = b.st[1];
        if (nloc == 0u) { xcd_barrier_complete(bar, b.x, nloc, nx); b.st[0] = nloc; b.st[1] = nx; }
        const unsigned old = xb_add(&bar[XB_XSUB(b.x)], 1u);
        const unsigned gen = old / nloc;
        if (old + 1u == (gen + 1u) * nloc) {
            __builtin_amdgcn_fence(__ATOMIC_RELEASE, "agent");
            asm volatile("s_waitcnt vmcnt(0)" ::: "memory");
            const unsigned og = xb_add(&bar[XB_TOP], 1u);
            const unsigned tg = og / nx;
            if (og + 1u == (tg + 1u) * nx) xb_add(&bar[XB_TOPGEN], 1u);
            else XB_SPIN(xb_ld(&bar[XB_TOPGEN]) == tg, bar);
            __builtin_amdgcn_fence(__ATOMIC_ACQUIRE, "agent");
            xb_add(&bar[XB_XGEN(b.x)], 1u);
            asm volatile("s_waitcnt vmcnt(0)" ::: "memory");
        } else {
            XB_SPIN(xb_ld(&bar[XB_XGEN(b.x)]) == gen, bar);
            __builtin_amdgcn_fence(__ATOMIC_ACQUIRE, "agent");
            asm volatile("s_waitcnt vmcnt(0)" ::: "memory");
        }
    }
    __syncthreads();
}

struct Args { const float* in[24]; float* out; unsigned char* ws; int ph_lo, ph_hi; };
enum { I_X = 0, I_C, I_CTX, I_CCTX, I_ANG, I_FNG, I_ADAW, I_ADAB, I_WIN, I_QKG, I_DLAM, I_DSUB, I_RPB, I_SINK, I_WBR, I_WOUT, I_FG, I_FU, I_FD, I_ROUTER, I_MG, I_MU, I_MD, I_FINALG };

struct Frame {
    LAS unsigned char* lds; int tid, lane, wave, G, gw, NGW;
    unsigned char* ws; unsigned* ctl; const float* const* in;
};
__device__ __forceinline__ int cond_of_panel(int pm) { return (pm % PPB == 0) ? 4 : pm / PPB; }
__device__ __forceinline__ int cond_of_row(int r) { return (r % RPB < CTXL) ? 4 : r / RPB; }
__device__ __forceinline__ const float* x0_row(const float* x, const float* ctx, int r) {
    const int b = r / RPB, rr = r % RPB;
    return rr < CTXL ? ctx + ((size_t)b * CTXL + rr) * D : x + ((size_t)b * SEQ + (rr - CTXL)) * D;
}

using pg8::Unit;
struct EpiInProj {
    static constexpr bool PERM = true;
    bf16_t* QKV; bf16_t* GATES;
    __device__ __forceinline__ void operator()(const f32x4 (&acc)[2][2][4][2], const Unit& u, int wr, int wc, int fr, int fq) const {
        const int row0 = u.pm * 256 + wr * 64 + fr; const bool gate = u.pn >= 20;
        bf16_t* base = gate ? GATES : QKV; const int ldc = gate ? LDG : LDQ; const int col0 = (gate ? (u.pn - 20) : u.pn) * 256 + wc * 32 + 8 * fq;
#pragma unroll
        for (int ai = 0; ai < 2; ++ai)
#pragma unroll
            for (int m = 0; m < 4; ++m) { bf16_t* rowp = base + (size_t)(row0 + ai * 128 + m * 16) * ldc + col0;
#pragma unroll
                for (int bj = 0; bj < 2; ++bj) { f32x4 v0 = acc[ai][bj][m][0], v1 = acc[ai][bj][m][1];
                    if (gate) {
#pragma unroll
                        for (int j = 0; j < 4; ++j) { v0[j] = sigmoid_f(v0[j]); v1[j] = sigmoid_f(v1[j]); } }
                    u32x4 w; w.x = cvt_pk_bf16(v0[0], v0[1]); w.y = cvt_pk_bf16(v0[2], v0[3]); w.z = cvt_pk_bf16(v1[0], v1[1]); w.w = cvt_pk_bf16(v1[2], v1[3]);
                    *(u32x4*)(rowp + bj * 128) = w; } }
    }
};
struct EpiResid {
    static constexpr bool PERM = false;
    const float* base_ws; const float* x_in; const float* ctx_in; float* out; const modacc_t* gmod;
    __device__ __forceinline__ void operator()(const f32x4 (&acc)[2][2][4][2], const Unit& u, int wr, int wc, int fr, int fq) const {
        const int rp = wr * 64 + fr, col0 = u.pn * 256 + wc * 32 + 4 * fq;
        const float* bp;
        if (base_ws) bp = base_ws + (size_t)u.pm * 256 * D;
        else { const int b = u.pm / PPB, pp = u.pm % PPB; bp = pp == 0 ? ctx_in + (size_t)b * CTXL * D : x_in + ((size_t)b * SEQ + (size_t)(pp - 1) * 256) * D; }
        float* op = out + (size_t)u.pm * 256 * D;
        const modacc_t* gv = gmod + (size_t)cond_of_panel(u.pm) * ADA + col0;
        f32x4 g[2][2];
#pragma unroll
        for (int bj = 0; bj < 2; ++bj)
#pragma unroll
            for (int n = 0; n < 2; ++n) g[bj][n] = mod4(gv + bj * 128 + n * 16);
#pragma unroll
        for (int ai = 0; ai < 2; ++ai)
#pragma unroll
            for (int m = 0; m < 4; ++m) { const size_t off = (size_t)(rp + ai * 128 + m * 16) * D + col0;
#pragma unroll
                for (int bj = 0; bj < 2; ++bj)
#pragma unroll
                    for (int n = 0; n < 2; ++n) { const f32x4 bs = *(const f32x4*)(bp + off + bj * 128 + n * 16);
                        *(f32x4*)(op + off + bj * 128 + n * 16) = bs + g[bj][n] * acc[ai][bj][m][n]; }
                asm volatile("" ::: "memory"); }
    }
};
struct EpiSwiglu {
    static constexpr bool PERM = true;
    bf16_t* ACT;
    __device__ __forceinline__ void operator()(const f32x4 (&acc)[2][2][4][2], const Unit& u, int wr, int wc, int fr, int fq) const {
        const int row0 = u.pm * 256 + wr * 64 + fr, col0 = u.pn * 128 + wc * 32 + 8 * fq;
#pragma unroll
        for (int ai = 0; ai < 2; ++ai)
#pragma unroll
            for (int m = 0; m < 4; ++m) { bf16_t* rowp = ACT + (size_t)(row0 + ai * 128 + m * 16) * DFF + col0;
                f32x4 y0, y1;
#pragma unroll
                for (int j = 0; j < 4; ++j) { const float g0 = acc[ai][0][m][0][j], g1 = acc[ai][0][m][1][j];
                    y0[j] = g0 * sigmoid_f(g0) * acc[ai][1][m][0][j]; y1[j] = g1 * sigmoid_f(g1) * acc[ai][1][m][1][j]; }
                u32x4 w; w.x = cvt_pk_bf16(y0[0], y0[1]); w.y = cvt_pk_bf16(y0[2], y0[3]); w.z = cvt_pk_bf16(y1[0], y1[1]); w.w = cvt_pk_bf16(y1[2], y1[3]);
                *(u32x4*)rowp = w; }
    }
};
struct EpiMerge {
    static constexpr bool PERM = true;
    const bf16_t* GATES; float* scr; bf16_t* OUT;
    __device__ __forceinline__ void operator()(const f32x4 (&acc)[2][2][4][2], const Unit& u, int wr, int wc, int fr, int fq) const {
        const int row0 = u.pm * 256 + wr * 64 + fr, colt = u.pn * 256 + wc * 32 + 8 * fq, br = u.aux, tid = threadIdx.x;
        __attribute__((address_space(1))) float* sp = (__attribute__((address_space(1))) float*)(scr + (size_t)tid * 4); asm volatile("" : "+v"(sp));
#pragma unroll
        for (int ai = 0; ai < 2; ++ai)
#pragma unroll
            for (int m = 0; m < 4; ++m) { const size_t roff = (size_t)(row0 + ai * 128 + m * 16);
#pragma unroll
                for (int bj = 0; bj < 2; ++bj) { const int slot = ((ai * 4 + m) * 2 + bj) * 2;
                    const u32x4 gw = *(const u32x4*)(GATES + roff * LDG + br * D + colt + bj * 128);
                    f32x4 g0 = {bflo(gw.x), bfhi(gw.x), bflo(gw.y), bfhi(gw.y)}, g1 = {bflo(gw.z), bfhi(gw.z), bflo(gw.w), bfhi(gw.w)};
                    f32x4 v0 = g0 * acc[ai][bj][m][0], v1 = g1 * acc[ai][bj][m][1];
                    if (br > 0) { v0 += *(const __attribute__((address_space(1))) f32x4*)(sp + (size_t)(slot + 0) * NTHREADS * 4); v1 += *(const __attribute__((address_space(1))) f32x4*)(sp + (size_t)(slot + 1) * NTHREADS * 4); }
                    if (br < 3) { *(__attribute__((address_space(1))) f32x4*)(sp + (size_t)(slot + 0) * NTHREADS * 4) = v0; *(__attribute__((address_space(1))) f32x4*)(sp + (size_t)(slot + 1) * NTHREADS * 4) = v1; }
                    else { u32x4 w; w.x = cvt_pk_bf16(v0[0], v0[1]); w.y = cvt_pk_bf16(v0[2], v0[3]); w.z = cvt_pk_bf16(v1[0], v1[1]); w.w = cvt_pk_bf16(v1[2], v1[3]);
                        *(u32x4*)(OUT + roff * D + colt + bj * 128) = w; } } }
    }
};
struct EpiBf16Plain {
    static constexpr bool PERM = true;
    bf16_t* O; int ldc;
    __device__ __forceinline__ void operator()(const f32x4 (&acc)[2][2][4][2], const Unit& u, int wr, int wc, int fr, int fq) const {
        const int row0 = u.pm * 256 + wr * 64 + fr, col0 = u.pn * 256 + wc * 32 + 8 * fq;
#pragma unroll
        for (int ai = 0; ai < 2; ++ai)
#pragma unroll
            for (int m = 0; m < 4; ++m) { bf16_t* rowp = O + (size_t)(row0 + ai * 128 + m * 16) * ldc + col0;
#pragma unroll
                for (int bj = 0; bj < 2; ++bj) { const f32x4 v0 = acc[ai][bj][m][0], v1 = acc[ai][bj][m][1];
                    u32x4 w; w.x = cvt_pk_bf16(v0[0], v0[1]); w.y = cvt_pk_bf16(v0[2], v0[3]); w.z = cvt_pk_bf16(v1[0], v1[1]); w.w = cvt_pk_bf16(v1[2], v1[3]);
                    *(u32x4*)(rowp + bj * 128) = w; } }
    }
};

struct SchedGrid {
    int nM, nN, G, c; bool lat_only; const char* A; const char* B; size_t strideA, strideB;
    __device__ __forceinline__ bool next(int i, Unit& u) const {
        const long L = (long)i * G + c; if (L >= (long)nM * nN) return false;
        int pmc, pn; pg8::tile_of((int)L, nM, nN, pmc, pn);
        const int pm = lat_only ? (pmc + pmc / 16 + 1) : pmc;
        u.pm = pm; u.pn = pn; u.aux = 0; u.A = A + (size_t)pm * strideA; u.B = B + (size_t)pn * strideB; return true;
    }
};
struct SchedMerge {
    int nM, G, c; bool lat_only; const char* O; const char* WB;
    __device__ __forceinline__ bool next(int i, Unit& u) const {
        const int ti = i >> 2, br = i & 3; const long L = (long)ti * G + c; if (L >= (long)nM * 8) return false;
        int pmc, pn; pg8::tile_of((int)L, nM, 8, pmc, pn);
        const int pm = lat_only ? (pmc + pmc / 16 + 1) : pmc;
        u.pm = pm; u.pn = pn; u.aux = br; u.A = O + (size_t)pm * 256 * D * 2 + (size_t)br * 512 * 2; u.B = WB + (size_t)pn * 256 * D * 2 + (size_t)br * 512 * 2; return true;
    }
};
struct SchedMoe {
    int np, nN, G, c; int pend[NEXP]; const char* A; const char* W; size_t strideA, strideB, strideE;
    __device__ __forceinline__ bool next(int i, Unit& u) const {
        const long L = (long)i * G + c; if (L >= (long)np * nN) return false;
        int p, pn; pg8::tile_of((int)L, np, nN, p, pn);
        int e = 0;
#pragma unroll
        for (int j = 0; j < NEXP - 1; ++j) e += (p >= pend[j]) ? 1 : 0;
        u.pm = p; u.pn = pn; u.aux = e; u.A = A + (size_t)p * strideA; u.B = W + (size_t)e * strideE + (size_t)pn * strideB; return true;
    }
};

__device__ __forceinline__ void cvt_item(const float* W, int K, int N, bf16_t* WT, int gu, int item, int lane) {
    const int nblk = N >> 5, kb = item / nblk, nb = item - kb * nblk, k0 = kb * 64, n0 = nb * 32, kc = lane & 7, nc = lane >> 3;
    const float* src = W + (size_t)(k0 + 8 * kc) * N + n0 + 4 * nc;
    f32x4 v[8];
#pragma unroll
    for (int i = 0; i < 8; ++i) v[i] = *(const f32x4*)(src + (size_t)i * N);
#pragma unroll
    for (int j = 0; j < 4; ++j) { const int n = n0 + 4 * nc + j; const int drow = gu == 0 ? n : (((n >> 7) << 8) + (gu - 1) * 128 + (n & 127));
        u32x4 w; w.x = cvt_pk_bf16(v[0][j], v[1][j]); w.y = cvt_pk_bf16(v[2][j], v[3][j]); w.z = cvt_pk_bf16(v[4][j], v[5][j]); w.w = cvt_pk_bf16(v[6][j], v[7][j]);
        *(u32x4*)(WT + (size_t)drow * K + k0 + 8 * kc) = w; }
}

__device__ __forceinline__ void phase_prologue(Frame& F) {
    if (blockIdx.x == 0) {
        f32x2* T128 = (f32x2*)(F.ws + WS_ROPE); f32x2* T64 = (f32x2*)(F.ws + WS_ROPE + 16384);
        for (int i = F.tid; i < 64 * 32; i += NTHREADS) { const int pos = i >> 5, j = i & 31; const float fr = powf(10000.0f, -(float)j / 32.0f); float s, c; sincosf((float)pos * fr, &s, &c); T128[i] = (f32x2){c, s}; }
        for (int i = F.tid; i < 64 * 16; i += NTHREADS) { const int pos = i >> 4, j = i & 15; const float fr = powf(10000.0f, -(float)j / 16.0f); float s, c; sincosf((float)pos * fr, &s, &c); T64[i] = (f32x2){c, s}; }
    }
    {
        LAS float* sact = (LAS float*)F.lds;
        for (int i = F.tid; i < 5 * D; i += NTHREADS) { const int cd = i / D, k = i - cd * D; const float v = cd < 4 ? F.in[I_C][cd * D + k] : F.in[I_CCTX][k]; sact[i] = v * sigmoid_f(v); }
        __syncthreads();
        unsigned long long* mod = (unsigned long long*)(F.ws + WS_MOD);
        for (int t = F.gw; t < 2 * 48 * 16; t += F.NGW) {
            const int l = t / (48 * 16), r = t - l * 48 * 16, jc = r >> 4, ks = r & 15;
            const float* w = F.in[I_ADAW] + ((size_t)l * D + (size_t)ks * 128) * ADA + jc * 256 + 4 * F.lane;
            f32x4 a[5];
#pragma unroll
            for (int cd = 0; cd < 5; ++cd) a[cd] = (f32x4){0.f, 0.f, 0.f, 0.f};
#pragma unroll 4
            for (int k = 0; k < 128; ++k) { const f32x4 wv = *(const f32x4*)(w + (size_t)k * ADA);
#pragma unroll
                for (int cd = 0; cd < 5; ++cd) a[cd] += sact[cd * D + ks * 128 + k] * wv; }
            if (ks == 0) { const f32x4 bv = *(const f32x4*)(F.in[I_ADAB] + (size_t)l * ADA + jc * 256 + 4 * F.lane);
#pragma unroll
                for (int cd = 0; cd < 5; ++cd) a[cd] += bv; }
#pragma unroll
            for (int cd = 0; cd < 5; ++cd) { unsigned long long* dst = mod + ((size_t)l * 5 + cd) * ADA + jc * 256 + 4 * F.lane;
#pragma unroll
                for (int j = 0; j < 4; ++j) atomicAdd(dst + j, (unsigned long long)(long long)(a[cd][j] * MOD_SCALE)); }
        }
        __syncthreads();
    }
    {
        constexpr int I_IN = 32 * 416, I_SQ = 32 * 64, I_F = 32 * 176, I_DN = 88 * 64;
        constexpr int PER_L = I_IN + 2 * I_SQ, N_DENSE = 3 * I_F, N_MOE = 24 * I_F, NITEMS = 2 * PER_L + N_DENSE + N_MOE;
        static_assert(I_F == I_DN, "gate/up/down item counts match");
        for (int it = F.gw; it < NITEMS; it += F.NGW) {
            int r = it;
            if (r < 2 * PER_L) { const int l = r / PER_L; r -= l * PER_L;
                if (r < I_IN) { cvt_item(F.in[I_WIN] + (size_t)l * D * INCOLS, D, INCOLS, (bf16_t*)(F.ws + WS_WIN + (size_t)l * 52 * MiB), 0, r, F.lane); continue; } r -= I_IN;
                if (r < I_SQ) { cvt_item(F.in[I_WBR] + (size_t)l * D * D, D, D, (bf16_t*)(F.ws + WS_WBR + (size_t)l * 8 * MiB), 0, r, F.lane); continue; } r -= I_SQ;
                cvt_item(F.in[I_WOUT] + (size_t)l * D * D, D, D, (bf16_t*)(F.ws + WS_WOUT + (size_t)l * 8 * MiB), 0, r, F.lane); continue; }
            r -= 2 * PER_L;
            if (r < N_DENSE) { const int k = r / I_F; r -= k * I_F;
                if (k == 0) cvt_item(F.in[I_FG], D, DFF, (bf16_t*)(F.ws + WS_WGU0), 1, r, F.lane);
                else if (k == 1) cvt_item(F.in[I_FU], D, DFF, (bf16_t*)(F.ws + WS_WGU0), 2, r, F.lane);
                else cvt_item(F.in[I_FD], DFF, D, (bf16_t*)(F.ws + WS_WD0), 0, r, F.lane);
                continue; }
            r -= N_DENSE;
            { const int q = r / I_F; r -= q * I_F; const int e = q / 3, k = q - e * 3;
                if (k == 0) cvt_item(F.in[I_MG] + (size_t)e * D * DFF, D, DFF, (bf16_t*)(F.ws + WS_WGUM + (size_t)e * 44 * MiB), 1, r, F.lane);
                else if (k == 1) cvt_item(F.in[I_MU] + (size_t)e * D * DFF, D, DFF, (bf16_t*)(F.ws + WS_WGUM + (size_t)e * 44 * MiB), 2, r, F.lane);
                else cvt_item(F.in[I_MD] + (size_t)e * DFF * D, DFF, D, (bf16_t*)(F.ws + WS_WDM + (size_t)e * 22 * MiB), 0, r, F.lane); }
        }
    }
}

__device__ __forceinline__ void norm_mod_row(const float* xrow, const float* g, const modacc_t* sh, const modacc_t* sc, bf16_t* hrow, int lane, f32x4 (&v)[8]) {
    float s = 0.f;
#pragma unroll
    for (int j = 0; j < 8; ++j) { v[j] = *(const f32x4*)(xrow + 4 * lane + 256 * j); s += (v[j][0] * v[j][0] + v[j][1] * v[j][1]) + (v[j][2] * v[j][2] + v[j][3] * v[j][3]); }
    const float rstd = 1.0f / sqrtf(wave_sum(s) * (1.0f / D) + NORM_EPS);
#pragma unroll
    for (int j = 0; j < 8; ++j) { const int c = 4 * lane + 256 * j; const f32x4 gg = *(const f32x4*)(g + c), sv = mod4(sh + c), cv = mod4(sc + c);
        v[j] = (v[j] * rstd * gg) * (1.0f + cv) + sv;
        u32x2 w; w.x = cvt_pk_bf16(v[j][0], v[j][1]); w.y = cvt_pk_bf16(v[j][2], v[j][3]); *(u32x2*)(hrow + c) = w; }
}
__device__ __forceinline__ void phase_norm(Frame& F, const float* src, const float* g, int layer, int chunk_sh, int chunk_sc, bool lat_only) {
    const modacc_t* mod = (const modacc_t*)(F.ws + WS_MOD) + (size_t)layer * 5 * ADA; bf16_t* H = (bf16_t*)(F.ws + WS_H);
    for (int r = F.gw; r < MROWS; r += F.NGW) {
        if (lat_only && (r % RPB) < CTXL) continue;
        const int cd = cond_of_row(r); const float* xr = src ? src + (size_t)r * D : x0_row(F.in[I_X], F.in[I_CTX], r);
        f32x4 v[8]; norm_mod_row(xr, g, mod + (size_t)cd * ADA + chunk_sh * D, mod + (size_t)cd * ADA + chunk_sc * D, H + (size_t)r * D, F.lane, v);
    }
}
__device__ __forceinline__ void phase_prep(Frame& F, int layer) {
    bf16_t* QKV = (bf16_t*)(F.ws + WS_QKV); const f32x2* T128 = (const f32x2*)(F.ws + WS_ROPE); const f32x2* T64 = (const f32x2*)(F.ws + WS_ROPE + 16384);
    const float* qkg = F.in[I_QKG] + (size_t)layer * 256;
    const int sub = F.lane & 7, grp = F.lane >> 3; const long NIT = (long)MROWS * 20;
    for (long base = (long)F.gw * 8; base < NIT; base += (long)F.NGW * 8) {
        const long it = base + grp; const int r = (int)(it / 20), ch = (int)(it - (long)r * 20);
        int col, kind; if (ch < 6) { col = C_GQ + ch * 128; kind = 0; } else if (ch < 14) { col = C_DQ + (ch - 6) * 128; kind = 1; } else { col = C_SQ + (ch - 14) * 128; kind = 2; }
        const int rr = r % RPB; const bool lat = rr >= CTXL; const int n = rr - CTXL, prow = n >> 6, pcol = n & 63;
        bf16_t* p = QKV + (size_t)r * LDQ + col;
        int o1, o2, j0, pos; const f32x2* tab;
        if (kind == 1) { const int mp = sub >> 2, seg = (sub >> 1) & 1; j0 = (sub & 1) * 8; o1 = mp * 64 + seg * 32 + j0; o2 = o1 + 16; pos = seg ? pcol : prow; tab = T64 + pos * 16 + j0; }
        else { const int seg = sub >> 2; j0 = (sub & 3) * 8; o1 = seg * 64 + j0; o2 = o1 + 32; pos = seg ? pcol : prow; tab = T128 + pos * 32 + j0; }
        if (kind != 0 && !lat) continue;
        const u32x4 w1 = *(const u32x4*)(p + o1), w2 = *(const u32x4*)(p + o2);
        float a[8] = {bflo(w1.x), bfhi(w1.x), bflo(w1.y), bfhi(w1.y), bflo(w1.z), bfhi(w1.z), bflo(w1.w), bfhi(w1.w)};
        float b[8] = {bflo(w2.x), bfhi(w2.x), bflo(w2.y), bfhi(w2.y), bflo(w2.z), bfhi(w2.z), bflo(w2.w), bfhi(w2.w)};
        if (kind == 0) {
            float s = 0.f;
#pragma unroll
            for (int j = 0; j < 8; ++j) s += a[j] * a[j] + b[j] * b[j];
            s += __shfl_xor(s, 1); s += __shfl_xor(s, 2); s += __shfl_xor(s, 4);
            const float rstd = 1.0f / sqrtf(s * (1.0f / 128.0f) + NORM_EPS); const float* gq = qkg + (ch < 4 ? 0 : 128);
#pragma unroll
            for (int j = 0; j < 8; ++j) { a[j] = a[j] * rstd * gq[o1 + j]; b[j] = b[j] * rstd * gq[o2 + j]; }
        }
        if (lat) {
#pragma unroll
            for (int j = 0; j < 8; ++j) { const f32x2 cs = tab[j]; const float x1 = a[j], x2 = b[j]; a[j] = x1 * cs.x - x2 * cs.y; b[j] = x1 * cs.y + x2 * cs.x; }
        }
        u32x4 q1, q2; q1.x = cvt_pk_bf16(a[0], a[1]); q1.y = cvt_pk_bf16(a[2], a[3]); q1.z = cvt_pk_bf16(a[4], a[5]); q1.w = cvt_pk_bf16(a[6], a[7]);
        q2.x = cvt_pk_bf16(b[0], b[1]); q2.y = cvt_pk_bf16(b[2], b[3]); q2.z = cvt_pk_bf16(b[4], b[5]); q2.w = cvt_pk_bf16(b[6], b[7]);
        *(u32x4*)(p + o1) = q1; *(u32x4*)(p + o2) = q2;
    }
}

template <class KF>
__device__ __forceinline__ void naive_pass(const bf16_t* QKV, int qrow, int qcol, int dqk, int kcol, int vcol, int nkeys, float scale, const KF& kf, bool has_sink, float sinkv,
                                           LAS float* qs, LAS unsigned char* kl, int lane, float (&o)[2]) {
    for (int d = lane; d < dqk; d += 64) qs[d] = bf2f(QKV[(size_t)qrow * LDQ + qcol + d]);
    LDS_WAIT();
    float m = -1e30f, l = 0.f; o[0] = 0.f; o[1] = 0.f;
    const int srow = lane >> 4, sc16 = lane & 15, nchunk16 = dqk >> 3;
    for (int c0 = 0; c0 < nkeys; c0 += 64) {
        const int i = c0 + lane; const bool valid = i < nkeys; int row = 0; float bias = 0.f;
        if (valid) kf(i, row, bias);
#pragma unroll 4
        for (int g = 0; g < 16; ++g) { const int rr = g * 4 + srow; const int grow = __shfl(row, rr);
            if (sc16 < nchunk16) *(LAS u32x4*)(kl + rr * 272 + sc16 * 16) = *(const u32x4*)(QKV + (size_t)grow * LDQ + kcol + sc16 * 8); }
        LDS_WAIT();
        float s = -1e30f;
        if (valid) { float dsum = 0.f;
            for (int d = 0; d < dqk; d += 8) { const u32x4 w = *(const LAS u32x4*)(kl + lane * 272 + d * 2); const f32x4 q0 = *(const LAS f32x4*)(qs + d), q1 = *(const LAS f32x4*)(qs + d + 4);
                dsum += bflo(w.x) * q0[0] + bfhi(w.x) * q0[1] + bflo(w.y) * q0[2] + bfhi(w.y) * q0[3] + bflo(w.z) * q1[0] + bfhi(w.z) * q1[1] + bflo(w.w) * q1[2] + bfhi(w.w) * q1[3]; }
            s = dsum * scale + bias; }
        LDS_WAIT();
        const float mn = fmaxf(m, wave_max(s)); const float alpha = __expf(m - mn); const float p = valid ? __expf(s - mn) : 0.f;
        l = l * alpha + wave_sum(p); o[0] *= alpha; o[1] *= alpha; m = mn;
#pragma unroll 8
        for (int k = 0; k < 64; ++k) { const float pk = __shfl(p, k); const int rk = __shfl(row, k);
            const unsigned w = *(const unsigned*)(QKV + (size_t)rk * LDQ + vcol + 2 * lane); o[0] += pk * bflo(w); o[1] += pk * bfhi(w); }
    }
    if (has_sink) l += __expf(sinkv - m);
    const float il = 1.0f / l; o[0] *= il; o[1] *= il;
}
__device__ __forceinline__ void phase_attn_naive(Frame& F, int layer, bool need_ctx) {
    const bf16_t* QKV = (const bf16_t*)(F.ws + WS_QKV); bf16_t* O = (bf16_t*)(F.ws + WS_O);
    LAS float* qs = (LAS float*)(F.lds + 8 * 17408) + F.wave * 128; LAS unsigned char* kl = F.lds + F.wave * 17408;
    const float* rpb = F.in[I_RPB] + (size_t)layer * 4 * 15 * 31; const float* sink = F.in[I_SINK] + layer * 4;
    const float* lp = F.in[I_DLAM] + layer * 256; const float* subg = F.in[I_DSUB] + layer * 128;
    const float lambda_init = 0.8f - 0.6f * expf(-0.3f * (float)layer);
    const float lam = __expf(wave_sum(lp[F.lane] * lp[64 + F.lane])) - __expf(wave_sum(lp[128 + F.lane] * lp[192 + F.lane])) + lambda_init;
    const long NIT = 4L * NB * 4 * RPB; const int lane = F.lane;
    for (long it = F.gw; it < NIT; it += F.NGW) {
        const int q = (int)(it % RPB); long t = it / RPB; const int h = (int)(t & 3); t >>= 2; const int b = (int)(t & 3); const int mixer = (int)(t >> 2);
        const bool isctx = q < CTXL; if (isctx && !need_ctx) continue;
        const int qrow = b * RPB + q, brow = b * RPB, n = q - CTXL; float o[2];
        auto kf_plain = [&](int i, int& row, float& bias) { row = brow + i; bias = 0.f; };
        if (mixer == 0) {
            naive_pass(QKV, qrow, C_GQ + h * 128, 128, C_GK + (h >> 1) * 128, C_GV + (h >> 1) * 128, isctx ? CTXL : RPB, 0.08838834764831845f, kf_plain, false, 0.f, qs, kl, lane, o);
        } else if (mixer == 1) {
            float o0[2], o1[2];
            naive_pass(QKV, qrow, C_DQ + h * 128, 64, C_DK + h * 128, C_DV + h * 128, isctx ? CTXL : RPB, 0.125f, kf_plain, false, 0.f, qs, kl, lane, o0);
            naive_pass(QKV, qrow, C_DQ + h * 128 + 64, 64, C_DK + h * 128 + 64, C_DV + h * 128, isctx ? CTXL : RPB, 0.125f, kf_plain, false, 0.f, qs, kl, lane, o1);
            o[0] = o0[0] - lam * o1[0]; o[1] = o0[1] - lam * o1[1];
            const float ms = wave_sum(o[0] * o[0] + o[1] * o[1]) * (1.0f / 128.0f); const float rstd = 1.0f / sqrtf(ms + NORM_EPS);
            o[0] = o[0] * rstd * subg[2 * lane] * (1.0f - lambda_init); o[1] = o[1] * rstd * subg[2 * lane + 1] * (1.0f - lambda_init);
        } else if (mixer == 2) {
            if (isctx) naive_pass(QKV, qrow, C_NQ + h * 128, 128, C_NK + h * 128, C_NV + h * 128, CTXL, 0.08838834764831845f, kf_plain, false, 0.f, qs, kl, lane, o);
            else {
                const int r = n >> 6, qc = n & 63; int rs = r - 4; rs = rs < 0 ? 0 : (rs > 56 ? 56 : rs); int cs = qc - 8; cs = cs < 0 ? 0 : (cs > 48 ? 48 : cs);
                const float* rp = rpb + h * 15 * 31;
                auto kf = [&](int i, int& row, float& bias) { if (i < CTXL) { row = brow + i; bias = 0.f; } else { const int ii = i - CTXL, kr = rs + (ii >> 4), kc = cs + (ii & 15);
                    row = brow + CTXL + kr * 64 + kc; bias = rp[(kr - r + 7) * 31 + (kc - qc + 15)]; } };
                naive_pass(QKV, qrow, C_NQ + h * 128, 128, C_NK + h * 128, C_NV + h * 128, CTXL + 128, 0.08838834764831845f, kf, false, 0.f, qs, kl, lane, o);
            }
        } else {
            if (isctx) naive_pass(QKV, qrow, C_SQ + h * 128, 128, C_SK + (h >> 1) * 128, C_SV + (h >> 1) * 128, CTXL, 0.08838834764831845f, kf_plain, true, sink[h], qs, kl, lane, o);
            else {
                const int lo = n - 128 < 0 ? 0 : n - 128, hi = n + 128 > SEQ - 1 ? SEQ - 1 : n + 128;
                auto kf = [&](int i, int& row, float& bias) { row = i < CTXL ? brow + i : brow + CTXL + lo + (i - CTXL); bias = 0.f; };
                naive_pass(QKV, qrow, C_SQ + h * 128, 128, C_SK + (h >> 1) * 128, C_SV + (h >> 1) * 128, CTXL + (hi - lo + 1), 0.08838834764831845f, kf, true, sink[h], qs, kl, lane, o);
            }
        }
        *(unsigned*)(O + (size_t)qrow * D + mixer * 512 + h * 128 + 2 * lane) = cvt_pk_bf16(o[0], o[1]);
    }
}

__device__ __forceinline__ void phase_norm_router(Frame& F, const float* X3) {
    LAS float* rt = (LAS float*)F.lds;
    for (int i = F.tid; i < D * NEXP; i += NTHREADS) { const int k = i >> 3, e = i & 7; rt[e * D + k] = F.in[I_ROUTER][i]; }
    __syncthreads();
    const modacc_t* mod = (const modacc_t*)(F.ws + WS_MOD) + (size_t)1 * 5 * ADA; bf16_t* H = (bf16_t*)(F.ws + WS_H);
    int* rt_e = (int*)(F.ws + WS_ROUTE); f32x2* rt_w = (f32x2*)(F.ws + WS_ROUTE + 65536);
    const float* g = F.in[I_FNG] + D;
    unsigned cnt[NEXP];
#pragma unroll
    for (int e = 0; e < NEXP; ++e) cnt[e] = 0u;
    for (int t = F.gw; t < NB * SEQ; t += F.NGW) {
        const int b = t >> 12, n = t & 4095, r = b * RPB + CTXL + n;
        f32x4 v[8]; norm_mod_row(X3 + (size_t)r * D, g, mod + (size_t)b * ADA + 3 * D, mod + (size_t)b * ADA + 4 * D, H + (size_t)r * D, F.lane, v);
        float lg[NEXP];
#pragma unroll
        for (int e = 0; e < NEXP; ++e) { float s = 0.f;
#pragma unroll
            for (int j = 0; j < 8; ++j) { const f32x4 w = *(const LAS f32x4*)(rt + e * D + 4 * F.lane + 256 * j); s += (v[j][0] * w[0] + v[j][1] * w[1]) + (v[j][2] * w[2] + v[j][3] * w[3]); }
            lg[e] = wave_sum(s); }
        float mx = lg[0];
#pragma unroll
        for (int e = 1; e < NEXP; ++e) mx = fmaxf(mx, lg[e]);
        float p[NEXP], ps = 0.f;
#pragma unroll
        for (int e = 0; e < NEXP; ++e) { p[e] = __expf(lg[e] - mx); ps += p[e]; }
        int e1 = 0; float p1 = p[0];
#pragma unroll
        for (int e = 1; e < NEXP; ++e) if (p[e] > p1) { p1 = p[e]; e1 = e; }
        int e2 = -1; float p2 = -1.f;
#pragma unroll
        for (int e = 0; e < NEXP; ++e) if (e != e1 && p[e] > p2) { p2 = p[e]; e2 = e; }
        const float inv = 1.0f / (p1 + p2);
        if (F.lane == 0) { rt_e[t] = e1 | (e2 << 8); rt_w[t] = (f32x2){p1 * inv, p2 * inv}; }
#pragma unroll
        for (int e = 0; e < NEXP; ++e) cnt[e] += (e == e1 || e == e2) ? 1u : 0u;
    }
    if (F.lane == 0) {
#pragma unroll
        for (int e = 0; e < NEXP; ++e) if (cnt[e]) atomicAdd(F.ctl + CW_CNT + e, cnt[e]);
    }
    __syncthreads();
}
__device__ __forceinline__ void moe_offsets(Frame& F, int (&cntv)[NEXP], int (&off)[NEXP + 1]) {
    off[0] = 0;
#pragma unroll
    for (int e = 0; e < NEXP; ++e) { cntv[e] = (int)__hip_atomic_load(F.ctl + CW_CNT + e, __ATOMIC_RELAXED, __HIP_MEMORY_SCOPE_AGENT); off[e + 1] = off[e] + ((cntv[e] + 255) & ~255); }
}
__device__ __forceinline__ void phase_gather(Frame& F) {
    int cntv[NEXP], off[NEXP + 1]; moe_offsets(F, cntv, off);
    const bf16_t* H = (const bf16_t*)(F.ws + WS_H); bf16_t* XS = (bf16_t*)(F.ws + WS_XS);
    const int* rt_e = (const int*)(F.ws + WS_ROUTE); int* rt_pos = (int*)(F.ws + WS_ROUTE + 65536 + 131072);
    for (int t = F.gw; t < NB * SEQ; t += F.NGW) {
        const int b = t >> 12, n = t & 4095, r = b * RPB + CTXL + n; const int ee = rt_e[t], e1 = ee & 255, e2 = ee >> 8;
        int p1 = 0, p2 = 0;
        if (F.lane == 0) { int o1 = 0, o2 = 0;
#pragma unroll
            for (int e = 0; e < NEXP; ++e) { o1 = (e == e1) ? off[e] : o1; o2 = (e == e2) ? off[e] : o2; }
            p1 = o1 + (int)atomicAdd(F.ctl + CW_CUR + e1, 1u); p2 = o2 + (int)atomicAdd(F.ctl + CW_CUR + e2, 1u);
            rt_pos[2 * t] = p1; rt_pos[2 * t + 1] = p2; }
        p1 = __shfl(p1, 0); p2 = __shfl(p2, 0);
        const u32x4* src = (const u32x4*)(H + (size_t)r * D); u32x4* d1 = (u32x4*)(XS + (size_t)p1 * D); u32x4* d2 = (u32x4*)(XS + (size_t)p2 * D);
#pragma unroll
        for (int j = 0; j < 4; ++j) { const u32x4 w = src[F.lane + 64 * j]; d1[F.lane + 64 * j] = w; d2[F.lane + 64 * j] = w; }
    }
#pragma unroll
    for (int e = 0; e < NEXP; ++e) { const int npad = off[e + 1] - off[e] - cntv[e];
        for (int j = F.gw; j < npad; j += F.NGW) { u32x4* d = (u32x4*)(XS + (size_t)(off[e] + cntv[e] + j) * D);
#pragma unroll
            for (int q = 0; q < 4; ++q) d[F.lane + 64 * q] = (u32x4){0u, 0u, 0u, 0u}; } }
}
__device__ __forceinline__ void phase_final(Frame& F, const float* X3, float* out) {
    const modacc_t* mod = (const modacc_t*)(F.ws + WS_MOD) + (size_t)1 * 5 * ADA; const bf16_t* Y2 = (const bf16_t*)(F.ws + WS_Y2);
    const f32x2* rt_w = (const f32x2*)(F.ws + WS_ROUTE + 65536); const int* rt_pos = (const int*)(F.ws + WS_ROUTE + 65536 + 131072);
    const float* fg = F.in[I_FINALG];
    for (int t = F.gw; t < NB * SEQ; t += F.NGW) {
        const int b = t >> 12, n = t & 4095, r = b * RPB + CTXL + n; const f32x2 w = rt_w[t]; const int p1 = rt_pos[2 * t], p2 = rt_pos[2 * t + 1];
        const float* xr = X3 + (size_t)r * D; const modacc_t* gf = mod + (size_t)b * ADA + 5 * D;
        f32x4 z[8]; float s = 0.f;
#pragma unroll
        for (int j = 0; j < 8; ++j) { const int c = 4 * F.lane + 256 * j; const u32x2 a = *(const u32x2*)(Y2 + (size_t)p1 * D + c), bb = *(const u32x2*)(Y2 + (size_t)p2 * D + c);
            const f32x4 ya = {bflo(a.x), bfhi(a.x), bflo(a.y), bfhi(a.y)}, yb = {bflo(bb.x), bfhi(bb.x), bflo(bb.y), bfhi(bb.y)};
            z[j] = *(const f32x4*)(xr + c) + mod4(gf + c) * (w.x * ya + w.y * yb);
            s += (z[j][0] * z[j][0] + z[j][1] * z[j][1]) + (z[j][2] * z[j][2] + z[j][3] * z[j][3]); }
        const float rstd = 1.0f / sqrtf(wave_sum(s) * (1.0f / D) + NORM_EPS);
#pragma unroll
        for (int j = 0; j < 8; ++j) { const int c = 4 * F.lane + 256 * j; *(f32x4*)(out + (size_t)t * D + c) = z[j] * rstd * *(const f32x4*)(fg + c); }
    }
}

#ifndef PH_MASK
#define PH_MASK 0xFFFFFFFFu
#endif
#define IN(k) (((PH_MASK >> (k)) & 1u) && lo <= (k) && (k) < hi)
#define SEAM(k) do { if (IN(k) && IN((k) + 1)) xcd_barrier(bar); } while (0)
template <int LAYER>
__device__ __forceinline__ void layer_common(Frame& F, const XcdBarrier& bar, const int lo, const int hi) {
    constexpr int pb = 1 + 9 * LAYER;
    constexpr bool lat_only = LAYER == 1;
    LAS unsigned char* ring = F.lds; const int cb = (int)blockIdx.x;
    if (IN(pb + 0)) phase_norm(F, LAYER == 0 ? nullptr : (const float*)(F.ws + WS_X2), F.in[I_ANG] + LAYER * D, LAYER, 0, 1, false);
    SEAM(pb + 0);
    if (IN(pb + 1)) {
        SchedGrid S{NPAN, INCOLS / 256, F.G, cb, false, (const char*)(F.ws + WS_H), (const char*)(F.ws + WS_WIN + (size_t)LAYER * 52 * MiB), (size_t)256 * D * 2, (size_t)256 * D * 2};
        EpiInProj E{(bf16_t*)(F.ws + WS_QKV), (bf16_t*)(F.ws + WS_GATES)};
        pg8::gemm_phase<EpiInProj, SchedGrid>(ring, pg8::Dims{D, D, D}, S, E);
    }
    SEAM(pb + 1);
    if (IN(pb + 2)) phase_prep(F, LAYER);
    SEAM(pb + 2);
    if (IN(pb + 3)) { phase_attn_naive(F, LAYER, LAYER == 0); __syncthreads(); }
    SEAM(pb + 3);
    if (IN(pb + 4)) {
        SchedMerge S{lat_only ? 64 : NPAN, F.G, cb, lat_only, (const char*)(F.ws + WS_O), (const char*)(F.ws + WS_WBR + (size_t)LAYER * 8 * MiB)};
        EpiMerge E{(const bf16_t*)(F.ws + WS_GATES), (float*)(F.ws + WS_SCR) + (size_t)blockIdx.x * 65536, (bf16_t*)(F.ws + WS_MERGED)};
        pg8::gemm_phase<EpiMerge, SchedMerge>(ring, pg8::Dims{D, D, 512}, S, E);
    }
    SEAM(pb + 4);
    if (IN(pb + 5)) {
        SchedGrid S{lat_only ? 64 : NPAN, 8, F.G, cb, lat_only, (const char*)(F.ws + WS_MERGED), (const char*)(F.ws + WS_WOUT + (size_t)LAYER * 8 * MiB), (size_t)256 * D * 2, (size_t)256 * D * 2};
        EpiResid E{LAYER == 0 ? nullptr : (const float*)(F.ws + WS_X2), F.in[I_X], F.in[I_CTX], (float*)(F.ws + WS_X1), (const modacc_t*)(F.ws + WS_MOD) + (size_t)LAYER * 5 * ADA + 2 * D};
        pg8::gemm_phase<EpiResid, SchedGrid>(ring, pg8::Dims{D, D, D}, S, E);
    }
    SEAM(pb + 5);
}
__device__ __forceinline__ void layer0_ffn(Frame& F, const XcdBarrier& bar, const int lo, const int hi) {
    LAS unsigned char* ring = F.lds; const int cb = (int)blockIdx.x;
    if (IN(7)) phase_norm(F, (const float*)(F.ws + WS_X1), F.in[I_FNG], 0, 3, 4, false);
    SEAM(7);
    if (IN(8)) {
        SchedGrid S{NPAN, 44, F.G, cb, false, (const char*)(F.ws + WS_H), (const char*)(F.ws + WS_WGU0), (size_t)256 * D * 2, (size_t)256 * D * 2};
        EpiSwiglu E{(bf16_t*)(F.ws + WS_ACT)};
        pg8::gemm_phase<EpiSwiglu, SchedGrid>(ring, pg8::Dims{D, D, D}, S, E);
    }
    SEAM(8);
    if (IN(9)) {
        SchedGrid S{NPAN, 8, F.G, cb, false, (const char*)(F.ws + WS_ACT), (const char*)(F.ws + WS_WD0), (size_t)256 * DFF * 2, (size_t)256 * DFF * 2};
        EpiResid E{(const float*)(F.ws + WS_X1), nullptr, nullptr, (float*)(F.ws + WS_X2), (const modacc_t*)(F.ws + WS_MOD) + 5 * D};
        pg8::gemm_phase<EpiResid, SchedGrid>(ring, pg8::Dims{DFF, DFF, DFF}, S, E);
    }
    SEAM(9);
}

constexpr int N_PHASES = 21;
__global__ void __launch_bounds__(NTHREADS, 2) fwd(Args args) {
    extern __shared__ __attribute__((aligned(16))) unsigned char lds_raw[];
    Frame F;
    F.lds = (LAS unsigned char*)lds_raw; F.tid = threadIdx.x; F.lane = F.tid & 63; F.wave = __builtin_amdgcn_readfirstlane(F.tid >> 6);
    F.G = gridDim.x; F.gw = blockIdx.x * NWAVES + F.wave; F.NGW = F.G * NWAVES; F.ws = args.ws; F.ctl = (unsigned*)(args.ws + WS_CTL); F.in = args.in;
    volatile LAS unsigned* MISC = (volatile LAS unsigned*)(F.lds + MISC_OFF);
    if (F.tid < 64) MISC[F.tid] = 0u;
    __syncthreads();
    XcdBarrier bar; bar.bar = F.ctl + CW_BAR; bar.x = 0; bar.st = nullptr;
    const bool one_launch = (args.ph_hi - args.ph_lo) > 1;
    if (one_launch) bar = xcd_barrier_post(F.ctl + CW_BAR, MISC + 8);
    const int lo = args.ph_lo, hi = args.ph_hi;
    LAS unsigned char* ring = F.lds;
    const int cb = (int)blockIdx.x;
    float* X1 = (float*)(F.ws + WS_X1); bf16_t* ACT = (bf16_t*)(F.ws + WS_ACT);

    if (IN(0)) phase_prologue(F);
    SEAM(0);
    layer_common<0>(F, bar, lo, hi);
    layer0_ffn(F, bar, lo, hi);
    layer_common<1>(F, bar, lo, hi);
    if (IN(16)) phase_norm_router(F, X1);
    SEAM(16);
    if (IN(17)) phase_gather(F);
    SEAM(17);
    if (IN(18) || IN(19)) {
        int cntv[NEXP], off[NEXP + 1]; moe_offsets(F, cntv, off);
        if (IN(18)) {
            SchedMoe S; S.np = off[NEXP] >> 8; S.nN = 44; S.G = F.G; S.c = cb;
#pragma unroll
            for (int e = 0; e < NEXP; ++e) S.pend[e] = off[e + 1] >> 8;
            S.A = (const char*)(F.ws + WS_XS); S.W = (const char*)(F.ws + WS_WGUM); S.strideA = (size_t)256 * D * 2; S.strideB = (size_t)256 * D * 2; S.strideE = (size_t)44 * MiB;
            EpiSwiglu E{ACT};
            pg8::gemm_phase<EpiSwiglu, SchedMoe>(ring, pg8::Dims{D, D, D}, S, E);
        }
        SEAM(18);
        if (IN(19)) {
            SchedMoe S; S.np = off[NEXP] >> 8; S.nN = 8; S.G = F.G; S.c = cb;
#pragma unroll
            for (int e = 0; e < NEXP; ++e) S.pend[e] = off[e + 1] >> 8;
            S.A = (const char*)ACT; S.W = (const char*)(F.ws + WS_WDM); S.strideA = (size_t)256 * DFF * 2; S.strideB = (size_t)256 * DFF * 2; S.strideE = (size_t)22 * MiB;
            EpiBf16Plain E{(bf16_t*)(F.ws + WS_Y2), D};
            pg8::gemm_phase<EpiBf16Plain, SchedMoe>(ring, pg8::Dims{DFF, DFF, DFF}, S, E);
        }
    }
    SEAM(19);
    if (IN(20)) phase_final(F, X1, args.out);
#undef IN
#undef SEAM
}

extern "C" void kernel_launch(void* const* d_in, const int* in_sizes, int n_in, void* d_out, int out_size, void* d_ws, size_t ws_size, hipStream_t stream) {
    static int grid = 0;
    if (grid == 0) {
        if (n_in != 24 || out_size != NB * SEQ * D || ws_size < WS_END) { fprintf(stderr, "kernel_launch: unexpected shapes (n_in %d out %d ws %zu, need %zu)\n", n_in, out_size, ws_size, (size_t)WS_END); grid = -1; return; }
        int dev = 0, cus = 0, per_cu = 0;
        if (hipGetDevice(&dev) != hipSuccess || hipDeviceGetAttribute(&cus, hipDeviceAttributeMultiprocessorCount, dev) != hipSuccess) { grid = -1; return; }
        if (hipFuncSetAttribute((const void*)fwd, hipFuncAttributeMaxDynamicSharedMemorySize, LDS_BYTES) != hipSuccess) { fprintf(stderr, "kernel_launch: hipFuncSetAttribute failed\n"); grid = -1; return; }
        if (hipOccupancyMaxActiveBlocksPerMultiprocessor(&per_cu, (const void*)fwd, NTHREADS, LDS_BYTES) != hipSuccess || per_cu < 1) fprintf(stderr, "kernel_launch: occupancy query says %d\n", per_cu);
        (void)hipGetLastError();
        grid = cus;
    }
    if (grid < 0) return;
    if (hipMemsetAsync((char*)d_ws + WS_CTL, 0, CTL_ZERO_BYTES, stream) != hipSuccess) return;
    Args a{};
    for (int i = 0; i < 24; ++i) a.in[i] = (const float*)d_in[i];
    a.out = (float*)d_out; a.ws = (unsigned char*)d_ws;
#if MK_PER_PHASE
    for (int p = 0; p < N_PHASES; ++p) { a.ph_lo = p; a.ph_hi = p + 1; hipLaunchKernelGGL(fwd, dim3(grid), dim3(NTHREADS), LDS_BYTES, stream, a); }
#else
    a.ph_lo = 0; a.ph_hi = N_PHASES; hipLaunchKernelGGL(fwd, dim3(grid), dim3(NTHREADS), LDS_BYTES, stream, a);
#endif
    const hipError_t le = hipPeekAtLastError();
    if (le != hipSuccess) fprintf(stderr, "kernel_launch: launch failed: %s\n", hipGetErrorName(le));
}
```

```cpp
#include <hip/hip_runtime.h>
#include <cstdio>
#include <cstdint>

#ifndef MK_PER_PHASE
#define MK_PER_PHASE 0
#endif

#define LAS __attribute__((address_space(3)))
typedef unsigned short bf16_t;
typedef short bf16x8 __attribute__((ext_vector_type(8)));
typedef float f32x4 __attribute__((ext_vector_type(4)));
typedef float f32x2 __attribute__((ext_vector_type(2)));
typedef unsigned u32x4 __attribute__((ext_vector_type(4)));
typedef unsigned u32x2 __attribute__((ext_vector_type(2)));

constexpr int NWAVES = 8, NTHREADS = 512;
constexpr int D = 2048, NB = 4, SEQ = 4096, CTXL = 256, RPB = 4352, MROWS = 17408, NPAN = 68, PPB = 17;
constexpr int LDQ = 5120, LDG = 8192, INCOLS = 13312, DFF = 5632, NEXP = 8, ADA = 12288;
constexpr int MOE_MAXPAN = 135;
constexpr float NORM_EPS = 1e-6f;
constexpr int C_GQ = 0, C_GK = 512, C_GV = 768, C_DQ = 1024, C_DK = 1536, C_DV = 2048, C_NQ = 2560, C_NK = 3072, C_NV = 3584, C_SQ = 4096, C_SK = 4608, C_SV = 4864;

constexpr size_t MiB = 1u << 20;
constexpr size_t WS_CTL = 0, CTL_ZERO_BYTES = 2 * MiB;
constexpr size_t WS_MOD = 1 * MiB;
constexpr size_t WS_ROPE = 2 * MiB;
constexpr size_t WS_ROUTE = 3 * MiB;
constexpr size_t WS_WIN = 4 * MiB;
constexpr size_t WS_WBR = 108 * MiB;
constexpr size_t WS_WOUT = 124 * MiB;
constexpr size_t WS_WGU0 = 140 * MiB;
constexpr size_t WS_WD0 = 184 * MiB;
constexpr size_t WS_WGUM = 206 * MiB;
constexpr size_t WS_WDM = 558 * MiB;
constexpr size_t WS_H = 734 * MiB;
constexpr size_t WS_QKV = 802 * MiB;
constexpr size_t WS_GATES = 972 * MiB;
constexpr size_t WS_ACT = WS_QKV;
constexpr size_t WS_O = 1244 * MiB;
constexpr size_t WS_MERGED = 1312 * MiB;
constexpr size_t WS_XS = WS_O;
constexpr size_t WS_X1 = 1380 * MiB;
constexpr size_t WS_X2 = 1516 * MiB;
constexpr size_t WS_SCR = WS_X1;
constexpr size_t WS_Y2 = WS_X2;
constexpr size_t WS_END = 1652 * MiB;
constexpr int CW_TMO = 0, CW_BAR = 4096, CW_CNT = 8192, CW_CUR = 8256;

constexpr int RING_BYTES = 131072, LDS_BYTES = 147456, MISC_OFF = LDS_BYTES - 512;

__device__ __forceinline__ unsigned cvt_pk_bf16(float lo, float hi) { unsigned r; asm volatile("v_cvt_pk_bf16_f32 %0, %1, %2" : "=v"(r) : "v"(lo), "v"(hi)); return r; }
__device__ __forceinline__ float bflo(unsigned w) { return __uint_as_float(w << 16); }
__device__ __forceinline__ float bfhi(unsigned w) { return __uint_as_float(w & 0xffff0000u); }
__device__ __forceinline__ float bf2f(bf16_t h) { return __uint_as_float(((unsigned)h) << 16); }
__device__ __forceinline__ float wave_sum(float v) {
#pragma unroll
    for (int o = 1; o < 64; o <<= 1) v += __shfl_xor(v, o);
    return v;
}
__device__ __forceinline__ float wave_max(float v) {
#pragma unroll
    for (int o = 1; o < 64; o <<= 1) v = fmaxf(v, __shfl_xor(v, o));
    return v;
}
__device__ __forceinline__ float sigmoid_f(float x) { return __builtin_amdgcn_rcpf(1.0f + __builtin_amdgcn_exp2f(-1.4426950408889634f * x)); }
typedef long long modacc_t;
constexpr float MOD_SCALE = 1099511627776.0f, MOD_INV = 1.0f / 1099511627776.0f;
__device__ __forceinline__ f32x4 mod4(const modacc_t* p) { return (f32x4){(float)p[0] * MOD_INV, (float)p[1] * MOD_INV, (float)p[2] * MOD_INV, (float)p[3] * MOD_INV}; }
#define LDS_WAIT() asm volatile("s_waitcnt lgkmcnt(0)" ::: "memory")
#define VM_WAIT() asm volatile("s_waitcnt vmcnt(0)" ::: "memory")

namespace pg8 {
#define PG8_LAS __attribute__((address_space(3)))
constexpr int BM = 256, BK = 64, HALF = 128, HTB = HALF * BK * 2, STAGE_BYTES = 8 * HTB;
__host__ __device__ __forceinline__ int lds_byte(int r, int c) { const int st = (r >> 4) * 2 + (c >> 5), rr = r & 15, cc = c & 31, ob = rr * 64 + cc * 2; return st * 1024 + (ob ^ (((ob >> 9) & 1) << 5)); }
__host__ __device__ __forceinline__ void stage_rc(int b, int& R, int& C) { const int st = b / 1024, sb = b % 1024, swz = sb ^ (((sb >> 9) & 1) << 5); R = (st >> 1) * 16 + swz / 64; C = (st & 1) * 32 + (swz % 64) / 2; }
__host__ __device__ __forceinline__ int perm32(int rho) { const int n = rho >> 4, i = rho & 15; return 8 * (i >> 2) + 4 * n + (i & 3); }

struct Unit { int pm, pn, aux; const char* A; const char* B; };
struct Dims { int lda, ldb, K; };

__device__ __forceinline__ void tile_of(int L, int nM, int nN, int& pm, int& pn) {
    const int nwg = nM * nN; int wgid = L;
    { const int q = nwg / 8, r = nwg % 8, xcd = wgid % 8, off = wgid / 8; wgid = (xcd < r ? xcd * (q + 1) : r * (q + 1) + (xcd - r) * q) + off; }
    const int nig = 8 * nN, gid = wgid / nig, fm = gid * 8, gsz = (nM - fm) < 8 ? (nM - fm) : 8;
    pm = fm + ((wgid % nig) % gsz); pn = (wgid % nig) / gsz;
}

template <class Epi, class Sched, bool ALIGN_EPI = true, bool SP2 = true>
__device__ __forceinline__ void gemm_phase(PG8_LAS unsigned char* lds, const Dims g, const Sched& S, const Epi& E) {
    const int tid = threadIdx.x, wid = __builtin_amdgcn_readfirstlane(tid >> 6), lane = tid & 63, wr = wid >> 2, wc = wid & 3, fr = lane & 15, fq = lane >> 4;
    const int nt = g.K / BK;
    unsigned voffA[2], voffB[2];
#pragma unroll
    for (int i = 0; i < 2; ++i) { int R, C; stage_rc(tid * 16 + i * 8192, R, C); const int Rb = Epi::PERM ? ((R & ~31) + perm32(R & 31)) : R;
        voffA[i] = (unsigned)(R * g.lda + C) * 2u; voffB[i] = (unsigned)(Rb * g.ldb + C) * 2u; }
    const size_t kstep = (size_t)(BK * 2);
    const size_t hstepA = (size_t)HALF * g.lda * 2, hstepB = (size_t)HALF * g.ldb * 2;
    const unsigned ldsw = (unsigned)wid * 1024u;
    const int aoff = lds_byte(wr * 64 + fr, fq * 8), boff = lds_byte(wc * 32 + fr, fq * 8);
#define PG8_SA(b, h) (((b) * 2 + (h)) * HTB)
#define PG8_SB(b, h) ((4 + (b) * 2 + (h)) * HTB)
#define PG8_STAGE(bufoff, gbase, voff) do { _Pragma("unroll") for (int _i = 0; _i < 2; ++_i) \
        __builtin_amdgcn_global_load_lds((const unsigned*)((const char*)(gbase) + (voff)[_i]), (PG8_LAS unsigned*)(lds + (bufoff) + ldsw + _i * 8192), 16, 0, 0); } while (0)
#define PG8_LDA(dst, b, h) do { _Pragma("unroll") for (int m = 0; m < 4; ++m) _Pragma("unroll") for (int k = 0; k < 2; ++k) dst[m][k] = *(const PG8_LAS bf16x8*)(lds + PG8_SA(b, h) + aoff + m * 2048 + k * 1024); } while (0)
#define PG8_LDB(dst, b, h) do { _Pragma("unroll") for (int n = 0; n < 2; ++n) _Pragma("unroll") for (int k = 0; k < 2; ++k) dst[n][k] = *(const PG8_LAS bf16x8*)(lds + PG8_SB(b, h) + boff + n * 2048 + k * 1024); } while (0)
#define PG8_MMA(ai, bj, At, Bt) do { __builtin_amdgcn_s_setprio(1); _Pragma("unroll") for (int m = 0; m < 4; ++m) _Pragma("unroll") for (int n = 0; n < 2; ++n) _Pragma("unroll") for (int k = 0; k < 2; ++k) \
        acc[ai][bj][m][n] = __builtin_amdgcn_mfma_f32_16x16x32_bf16(Bt[n][k], At[m][k], acc[ai][bj][m][n], 0, 0, 0); __builtin_amdgcn_s_setprio(0); } while (0)
#define PG8_WAIT_V(n) asm volatile("s_waitcnt vmcnt(" #n ")" ::: "memory")
#define PG8_WAIT_L(n) asm volatile("s_waitcnt lgkmcnt(" #n ")" ::: "memory")
#define PG8_BAR __builtin_amdgcn_s_barrier()
#define PG8_SCHED __builtin_amdgcn_sched_barrier(0)
    Unit cur, nxt; int ui = 0;
    if (!S.next(0, cur)) return;
    f32x4 acc[2][2][4][2];
#pragma unroll
    for (int a = 0; a < 2; ++a)
#pragma unroll
        for (int b = 0; b < 2; ++b)
#pragma unroll
            for (int m = 0; m < 4; ++m)
#pragma unroll
                for (int n = 0; n < 2; ++n) acc[a][b][m][n] = (f32x4){0.f, 0.f, 0.f, 0.f};
    bf16x8 At[4][2], B0[2][2], B1[2][2];
    const char* cA = cur.A; const char* cB = cur.B;
    if constexpr (SP2) {
        PG8_STAGE(PG8_SB(0, 0), cB, voffB); PG8_STAGE(PG8_SB(0, 1), cB + hstepB, voffB); PG8_STAGE(PG8_SA(0, 0), cA, voffA); PG8_STAGE(PG8_SA(0, 1), cA + hstepA, voffA);
        if (wr == 1) PG8_BAR;
        PG8_WAIT_V(2); PG8_BAR;
        PG8_STAGE(PG8_SB(1, 0), cB + kstep, voffB); PG8_STAGE(PG8_SA(1, 0), cA + kstep, voffA); PG8_STAGE(PG8_SB(1, 1), cB + hstepB + kstep, voffB);
        PG8_WAIT_V(6); PG8_BAR;
    } else {
        PG8_STAGE(PG8_SB(0, 0), cB, voffB); PG8_STAGE(PG8_SA(0, 0), cA, voffA); PG8_STAGE(PG8_SB(0, 1), cB + hstepB, voffB); PG8_STAGE(PG8_SA(0, 1), cA + hstepA, voffA);
        if (wr == 1) PG8_BAR;
        PG8_WAIT_V(4); PG8_BAR;
        PG8_STAGE(PG8_SB(1, 0), cB + kstep, voffB); PG8_STAGE(PG8_SA(1, 0), cA + kstep, voffA); PG8_STAGE(PG8_SB(1, 1), cB + hstepB + kstep, voffB);
        PG8_WAIT_V(6); PG8_BAR;
    }
    for (;;) {
        const bool has_next = S.next(ui + 1, nxt);
        const char* nA = has_next ? nxt.A : cA; const char* nB = has_next ? nxt.B : cB;
        for (int t = 0; t < nt; t += 2) {
            const bool last = (t == nt - 2);
            const char* a1 = cA + (size_t)(t + 1) * kstep;
            const char* a2 = last ? nA : cA + (size_t)(t + 2) * kstep; const char* b2 = last ? nB : cB + (size_t)(t + 2) * kstep;
            const char* a3 = a2 + kstep; const char* b3 = b2 + kstep;
            if constexpr (SP2) {
            PG8_LDB(B0, 0, 0); PG8_LDB(B1, 0, 1); PG8_SCHED; PG8_LDA(At, 0, 0); PG8_STAGE(PG8_SA(1, 1), a1 + hstepA, voffA);
            PG8_WAIT_V(8); PG8_WAIT_L(0); PG8_BAR; PG8_MMA(0, 0, At, B0); PG8_MMA(0, 1, At, B1); PG8_BAR; PG8_SCHED;
            PG8_LDA(At, 0, 1); PG8_STAGE(PG8_SB(0, 0), b2, voffB); PG8_STAGE(PG8_SB(0, 1), b2 + hstepB, voffB); PG8_STAGE(PG8_SA(0, 0), a2, voffA);
            PG8_WAIT_V(8); PG8_WAIT_L(0); PG8_BAR; PG8_MMA(1, 0, At, B0); PG8_MMA(1, 1, At, B1); PG8_BAR; PG8_SCHED;
            PG8_LDB(B0, 1, 0); PG8_LDB(B1, 1, 1); PG8_SCHED; PG8_LDA(At, 1, 0); PG8_STAGE(PG8_SA(0, 1), a2 + hstepA, voffA);
            PG8_WAIT_V(8); PG8_WAIT_L(0); PG8_BAR; PG8_MMA(0, 0, At, B0); PG8_MMA(0, 1, At, B1); PG8_BAR; PG8_SCHED;
            PG8_LDA(At, 1, 1); PG8_STAGE(PG8_SB(1, 0), b3, voffB); PG8_STAGE(PG8_SB(1, 1), b3 + hstepB, voffB); PG8_STAGE(PG8_SA(1, 0), a3, voffA);
            PG8_WAIT_V(8); PG8_WAIT_L(0); PG8_BAR; PG8_MMA(1, 0, At, B0); PG8_MMA(1, 1, At, B1); PG8_BAR; PG8_SCHED;
            } else {
            PG8_LDB(B0, 0, 0); PG8_SCHED; PG8_LDA(At, 0, 0); PG8_STAGE(PG8_SA(1, 1), a1 + hstepA, voffA);
            PG8_WAIT_L(8); PG8_BAR; PG8_WAIT_L(0); PG8_MMA(0, 0, At, B0); PG8_BAR; PG8_SCHED;
            PG8_LDB(B1, 0, 1); PG8_STAGE(PG8_SB(0, 0), b2, voffB);
            PG8_BAR; PG8_WAIT_L(0); PG8_MMA(0, 1, At, B1); PG8_BAR;
            PG8_LDA(At, 0, 1); PG8_STAGE(PG8_SA(0, 0), a2, voffA);
            PG8_BAR; PG8_WAIT_L(0); PG8_MMA(1, 0, At, B0); PG8_BAR; PG8_SCHED;
            PG8_STAGE(PG8_SB(0, 1), b2 + hstepB, voffB);
            PG8_WAIT_V(6); PG8_BAR; PG8_MMA(1, 1, At, B1); PG8_BAR;
            PG8_LDB(B0, 1, 0); PG8_SCHED; PG8_LDA(At, 1, 0); PG8_STAGE(PG8_SA(0, 1), a2 + hstepA, voffA);
            PG8_WAIT_L(8); PG8_BAR; PG8_WAIT_L(0); PG8_MMA(0, 0, At, B0); PG8_BAR; PG8_SCHED;
            PG8_LDB(B1, 1, 1); PG8_STAGE(PG8_SB(1, 0), b3, voffB);
            PG8_BAR; PG8_WAIT_L(0); PG8_MMA(0, 1, At, B1); PG8_BAR;
            PG8_LDA(At, 1, 1); PG8_STAGE(PG8_SA(1, 0), a3, voffA);
            PG8_BAR; PG8_WAIT_L(0); PG8_MMA(1, 0, At, B0); PG8_BAR; PG8_SCHED;
            PG8_STAGE(PG8_SB(1, 1), b3 + hstepB, voffB);
            PG8_WAIT_V(6); PG8_BAR; PG8_MMA(1, 1, At, B1); PG8_BAR;
            }
        }
        if constexpr (ALIGN_EPI) { if (wr == 0) PG8_BAR; }
        E(acc, cur, wr, wc, fr, fq);
        if (!has_next) break;
#pragma unroll
        for (int a = 0; a < 2; ++a)
#pragma unroll
            for (int b = 0; b < 2; ++b)
#pragma unroll
                for (int m = 0; m < 4; ++m)
#pragma unroll
                    for (int n = 0; n < 2; ++n) acc[a][b][m][n] = (f32x4){0.f, 0.f, 0.f, 0.f};
        cur = nxt; cA = nA; cB = nB; ++ui;
        if constexpr (ALIGN_EPI) { if (wr == 1) PG8_BAR; }
    }
    PG8_WAIT_V(0);
    if constexpr (!ALIGN_EPI) { if (wr == 0) PG8_BAR; }
    PG8_BAR;
#undef PG8_SA
#undef PG8_SB
#undef PG8_STAGE
#undef PG8_LDA
#undef PG8_LDB
#undef PG8_MMA
#undef PG8_WAIT_V
#undef PG8_WAIT_L
#undef PG8_BAR
#undef PG8_SCHED
}
}

#define XB_TMO      128
#define XB_XCNT(j)  (256  + 64 * (j))
#define XB_XSUB(j)  (1280 + 64 * (j))
#define XB_XGEN(j)  (2304 + 64 * (j))
#define XB_TOP      3328
#define XB_TOPGEN   3392
#define XCD_BAR_WORDS 3456
#define XB_SPIN_CAP (1u << 18)
__device__ __forceinline__ unsigned xb_ld(unsigned* p)              { return __hip_atomic_load(p, __ATOMIC_RELAXED, __HIP_MEMORY_SCOPE_AGENT); }
__device__ __forceinline__ unsigned xb_add(unsigned* p, unsigned v) { return __hip_atomic_fetch_add(p, v, __ATOMIC_RELAXED, __HIP_MEMORY_SCOPE_AGENT); }
__device__ __forceinline__ unsigned xb_xcc_id() { return (unsigned)__builtin_amdgcn_s_getreg((3 << 11) | 20) & 0xFu; }
#define XB_SPIN(cond, bar) do { unsigned _sp = 0; while (cond) { __builtin_amdgcn_s_sleep(1); \
    if ((++_sp & 255u) == 0u) { if (xb_ld(&(bar)[XB_TMO])) break; if (_sp > XB_SPIN_CAP) { atomicAdd(&(bar)[XB_TMO], 1u); break; } } } } while (0)
struct XcdBarrier { unsigned* bar; unsigned x; volatile LAS unsigned* st; };
__device__ __forceinline__ XcdBarrier xcd_barrier_post(unsigned* bar, volatile LAS unsigned* st) {
    XcdBarrier b; b.bar = bar; b.x = xb_xcc_id(); b.st = st;
    if (threadIdx.x == 0) (void)xb_add(&bar[XB_XCNT(b.x)], 1u);
    return b;
}
__device__ __forceinline__ void xcd_barrier_complete(unsigned* bar, unsigned x, unsigned& nloc, unsigned& nx) {
    const unsigned G = gridDim.x * gridDim.y * gridDim.z;
    unsigned sum, cnt, mine, sp = 0u;
    for (;;) {
        sum = 0u; cnt = 0u; mine = 0u;
#pragma unroll
        for (unsigned j = 0; j < 16; ++j) { const unsigned c = xb_ld(&bar[XB_XCNT(j)]); sum += c; cnt += (c > 0u) ? 1u : 0u; mine = (j == x) ? c : mine; }
        if (sum == G) break;
        __builtin_amdgcn_s_sleep(1);
        if ((++sp & 255u) == 0u) { if (xb_ld(&bar[XB_TMO])) break; if (sp > XB_SPIN_CAP) { atomicAdd(&bar[XB_TMO], 1u); break; } }
    }
    nloc = mine > 0u ? mine : 1u; nx = cnt > 0u ? cnt : 1u;
}
__device__ __forceinline__ void xcd_barrier(const XcdBarrier& b) {
    asm volatile("s_waitcnt vmcnt(0)" ::: "memory");
    __syncthreads();
    if (threadIdx.x == 0) {
        unsigned* bar = b.bar;
        __builtin_amdgcn_s_waitcnt(0);
        unsigned nloc = b.st[0], nx = b.st[1];
        if (nloc == 0u) { xcd_barrier_complete(bar, b.x, nloc, nx); b.st[0] = nloc; b.st[1] = nx; }
        const unsigned old = xb_add(&bar[XB_XSUB(b.x)], 1u);
        const unsigned gen = old / nloc;
        if (old + 1u == (gen + 1u) * nloc) {
            __builtin_amdgcn_fence(__ATOMIC_RELEASE, "agent");
            asm volatile("s_waitcnt vmcnt(0)" ::: "memory");
            const unsigned og = xb_add(&bar[XB_TOP], 1u);
            const unsigned tg = og / nx;
            if (og + 1u == (tg + 1u) * nx) xb_add(&bar[XB_TOPGEN], 1u);
            else XB_SPIN(xb_ld(&bar[XB_TOPGEN]) == tg, bar);
            __builtin_amdgcn_fence(__ATOMIC_ACQUIRE, "agent");
            xb_add(&bar[XB_XGEN(b.x)], 1u);
            asm volatile("s_waitcnt vmcnt(0)" ::: "memory");
        } else {
            XB_SPIN(xb_ld(&bar[XB_XGEN(b.x)]) == gen, bar);
            __builtin_amdgcn_fence(__ATOMIC_ACQUIRE, "agent");
            asm volatile("s_waitcnt vmcnt(0)" ::: "memory");
        }
    }
    __syncthreads();
}

struct Args { const float* in[24]; float* out; unsigned char* ws; int ph_lo, ph_hi; };
enum { I_X = 0, I_C, I_CTX, I_CCTX, I_ANG, I_FNG, I_ADAW, I_ADAB, I_WIN, I_QKG, I_DLAM, I_DSUB, I_RPB, I_SINK, I_WBR, I_WOUT, I_FG, I_FU, I_FD, I_ROUTER, I_MG, I_MU, I_MD, I_FINALG };

struct Frame {
    LAS unsigned char* lds; int tid, lane, wave, G, gw, NGW;
    unsigned char* ws; unsigned* ctl; const float* const* in;
};
__device__ __forceinline__ int cond_of_panel(int pm) { return (pm % PPB == 0) ? 4 : pm / PPB; }
__device__ __forceinline__ int cond_of_row(int r) { return (r % RPB < CTXL) ? 4 : r / RPB; }
__device__ __forceinline__ const float* x0_row(const float* x, const float* ctx, int r) {
    const int b = r / RPB, rr = r % RPB;
    return rr < CTXL ? ctx + ((size_t)b * CTXL + rr) * D : x + ((size_t)b * SEQ + (rr - CTXL)) * D;
}

using pg8::Unit;
struct EpiInProj {
    static constexpr bool PERM = true;
    bf16_t* QKV; bf16_t* GATES;
    __device__ __forceinline__ void operator()(const f32x4 (&acc)[2][2][4][2], const Unit& u, int wr, int wc, int fr, int fq) const {
        const int row0 = u.pm * 256 + wr * 64 + fr; const bool gate = u.pn >= 20;
        bf16_t* base = gate ? GATES : QKV; const int ldc = gate ? LDG : LDQ; const int col0 = (gate ? (u.pn - 20) : u.pn) * 256 + wc * 32 + 8 * fq;
#pragma unroll
        for (int ai = 0; ai < 2; ++ai)
#pragma unroll
            for (int m = 0; m < 4; ++m) { bf16_t* rowp = base + (size_t)(row0 + ai * 128 + m * 16) * ldc + col0;
#pragma unroll
                for (int bj = 0; bj < 2; ++bj) { f32x4 v0 = acc[ai][bj][m][0], v1 = acc[ai][bj][m][1];
                    if (gate) {
#pragma unroll
                        for (int j = 0; j < 4; ++j) { v0[j] = sigmoid_f(v0[j]); v1[j] = sigmoid_f(v1[j]); } }
                    u32x4 w; w.x = cvt_pk_bf16(v0[0], v0[1]); w.y = cvt_pk_bf16(v0[2], v0[3]); w.z = cvt_pk_bf16(v1[0], v1[1]); w.w = cvt_pk_bf16(v1[2], v1[3]);
                    *(u32x4*)(rowp + bj * 128) = w; } }
    }
};
struct EpiResid {
    static constexpr bool PERM = false;
    const float* base_ws; const float* x_in; const float* ctx_in; float* out; const modacc_t* gmod;
    __device__ __forceinline__ void operator()(const f32x4 (&acc)[2][2][4][2], const Unit& u, int wr, int wc, int fr, int fq) const {
        const int rp = wr * 64 + fr, col0 = u.pn * 256 + wc * 32 + 4 * fq;
        const float* bp;
        if (base_ws) bp = base_ws + (size_t)u.pm * 256 * D;
        else { const int b = u.pm / PPB, pp = u.pm % PPB; bp = pp == 0 ? ctx_in + (size_t)b * CTXL * D : x_in + ((size_t)b * SEQ + (size_t)(pp - 1) * 256) * D; }
        float* op = out + (size_t)u.pm * 256 * D;
        const modacc_t* gv = gmod + (size_t)cond_of_panel(u.pm) * ADA + col0;
        f32x4 g[2][2];
#pragma unroll
        for (int bj = 0; bj < 2; ++bj)
#pragma unroll
            for (int n = 0; n < 2; ++n) g[bj][n] = mod4(gv + bj * 128 + n * 16);
#pragma unroll
        for (int ai = 0; ai < 2; ++ai)
#pragma unroll
            for (int m = 0; m < 4; ++m) { const size_t off = (size_t)(rp + ai * 128 + m * 16) * D + col0;
#pragma unroll
                for (int bj = 0; bj < 2; ++bj)
#pragma unroll
                    for (int n = 0; n < 2; ++n) { const f32x4 bs = *(const f32x4*)(bp + off + bj * 128 + n * 16);
                        *(f32x4*)(op + off + bj * 128 + n * 16) = bs + g[bj][n] * acc[ai][bj][m][n]; }
                asm volatile("" ::: "memory"); }
    }
};
struct EpiSwiglu {
    static constexpr bool PERM = true;
    bf16_t* ACT;
    __device__ __forceinline__ void operator()(const f32x4 (&acc)[2][2][4][2], const Unit& u, int wr, int wc, int fr, int fq) const {
        const int row0 = u.pm * 256 + wr * 64 + fr, col0 = u.pn * 128 + wc * 32 + 8 * fq;
#pragma unroll
        for (int ai = 0; ai < 2; ++ai)
#pragma unroll
            for (int m = 0; m < 4; ++m) { bf16_t* rowp = ACT + (size_t)(row0 + ai * 128 + m * 16) * DFF + col0;
                f32x4 y0, y1;
#pragma unroll
                for (int j = 0; j < 4; ++j) { const float g0 = acc[ai][0][m][0][j], g1 = acc[ai][0][m][1][j];
                    y0[j] = g0 * sigmoid_f(g0) * acc[ai][1][m][0][j]; y1[j] = g1 * sigmoid_f(g1) * acc[ai][1][m][1][j]; }
                u32x4 w; w.x = cvt_pk_bf16(y0[0], y0[1]); w.y = cvt_pk_bf16(y0[2], y0[3]); w.z = cvt_pk_bf16(y1[0], y1[1]); w.w = cvt_pk_bf16(y1[2], y1[3]);
                *(u32x4*)rowp = w; }
    }
};
struct EpiMerge {
    static constexpr bool PERM = true;
    const bf16_t* GATES; float* scr; bf16_t* OUT;
    __device__ __forceinline__ void operator()(const f32x4 (&acc)[2][2][4][2], const Unit& u, int wr, int wc, int fr, int fq) const {
        const int row0 = u.pm * 256 + wr * 64 + fr, colt = u.pn * 256 + wc * 32 + 8 * fq, br = u.aux, tid = threadIdx.x;
        __attribute__((address_space(1))) float* sp = (__attribute__((address_space(1))) float*)(scr + (size_t)tid * 4); asm volatile("" : "+v"(sp));
#pragma unroll
        for (int ai = 0; ai < 2; ++ai)
#pragma unroll
            for (int m = 0; m < 4; ++m) { const size_t roff = (size_t)(row0 + ai * 128 + m * 16);
#pragma unroll
                for (int bj = 0; bj < 2; ++bj) { const int slot = ((ai * 4 + m) * 2 + bj) * 2;
                    const u32x4 gw = *(const u32x4*)(GATES + roff * LDG + br * D + colt + bj * 128);
                    f32x4 g0 = {bflo(gw.x), bfhi(gw.x), bflo(gw.y), bfhi(gw.y)}, g1 = {bflo(gw.z), bfhi(gw.z), bflo(gw.w), bfhi(gw.w)};
                    f32x4 v0 = g0 * acc[ai][bj][m][0], v1 = g1 * acc[ai][bj][m][1];
                    if (br > 0) { v0 += *(const __attribute__((address_space(1))) f32x4*)(sp + (size_t)(slot + 0) * NTHREADS * 4); v1 += *(const __attribute__((address_space(1))) f32x4*)(sp + (size_t)(slot + 1) * NTHREADS * 4); }
                    if (br < 3) { *(__attribute__((address_space(1))) f32x4*)(sp + (size_t)(slot + 0) * NTHREADS * 4) = v0; *(__attribute__((address_space(1))) f32x4*)(sp + (size_t)(slot + 1) * NTHREADS * 4) = v1; }
                    else { u32x4 w; w.x = cvt_pk_bf16(v0[0], v0[1]); w.y = cvt_pk_bf16(v0[2], v0[3]); w.z = cvt_pk_bf16(v1[0], v1[1]); w.w = cvt_pk_bf16(v1[2], v1[3]);
                        *(u32x4*)(OUT + roff * D + colt + bj * 128) = w; } } }
    }
};
struct EpiBf16Plain {
    static constexpr bool PERM = true;
    bf16_t* O; int ldc;
    __device__ __forceinline__ void operator()(const f32x4 (&acc)[2][2][4][2], const Unit& u, int wr, int wc, int fr, int fq) const {
        const int row0 = u.pm * 256 + wr * 64 + fr, col0 = u.pn * 256 + wc * 32 + 8 * fq;
#pragma unroll
        for (int ai = 0; ai < 2; ++ai)
#pragma unroll
            for (int m = 0; m < 4; ++m) { bf16_t* rowp = O + (size_t)(row0 + ai * 128 + m * 16) * ldc + col0;
#pragma unroll
                for (int bj = 0; bj < 2; ++bj) { const f32x4 v0 = acc[ai][bj][m][0], v1 = acc[ai][bj][m][1];
                    u32x4 w; w.x = cvt_pk_bf16(v0[0], v0[1]); w.y = cvt_pk_bf16(v0[2], v0[3]); w.z = cvt_pk_bf16(v1[0], v1[1]); w.w = cvt_pk_bf16(v1[2], v1[3]);
                    *(u32x4*)(rowp + bj * 128) = w; } }
    }
};

struct SchedGrid {
    int nM, nN, G, c; bool lat_only; const char* A; const char* B; size_t strideA, strideB;
    __device__ __forceinline__ bool next(int i, Unit& u) const {
        const long L = (long)i * G + c; if (L >= (long)nM * nN) return false;
        int pmc, pn; pg8::tile_of((int)L, nM, nN, pmc, pn);
        const int pm = lat_only ? (pmc + pmc / 16 + 1) : pmc;
        u.pm = pm; u.pn = pn; u.aux = 0; u.A = A + (size_t)pm * strideA; u.B = B + (size_t)pn * strideB; return true;
    }
};
struct SchedMerge {
    int nM, G, c; bool lat_only; const char* O; const char* WB;
    __device__ __forceinline__ bool next(int i, Unit& u) const {
        const int ti = i >> 2, br = i & 3; const long L = (long)ti * G + c; if (L >= (long)nM * 8) return false;
        int pmc, pn; pg8::tile_of((int)L, nM, 8, pmc, pn);
        const int pm = lat_only ? (pmc + pmc / 16 + 1) : pmc;
        u.pm = pm; u.pn = pn; u.aux = br; u.A = O + (size_t)pm * 256 * D * 2 + (size_t)br * 512 * 2; u.B = WB + (size_t)pn * 256 * D * 2 + (size_t)br * 512 * 2; return true;
    }
};
struct SchedMoe {
    int np, nN, G, c; int pend[NEXP]; const char* A; const char* W; size_t strideA, strideB, strideE;
    __device__ __forceinline__ bool next(int i, Unit& u) const {
        const long L = (long)i * G + c; if (L >= (long)np * nN) return false;
        int p, pn; pg8::tile_of((int)L, np, nN, p, pn);
        int e = 0;
#pragma unroll
        for (int j = 0; j < NEXP - 1; ++j) e += (p >= pend[j]) ? 1 : 0;
        u.pm = p; u.pn = pn; u.aux = e; u.A = A + (size_t)p * strideA; u.B = W + (size_t)e * strideE + (size_t)pn * strideB; return true;
    }
};

__device__ __forceinline__ void cvt_item(const float* W, int K, int N, bf16_t* WT, int gu, int item, int lane) {
    const int nblk = N >> 5, kb = item / nblk, nb = item - kb * nblk, k0 = kb * 64, n0 = nb * 32, kc = lane & 7, nc = lane >> 3;
    const float* src = W + (size_t)(k0 + 8 * kc) * N + n0 + 4 * nc;
    f32x4 v[8];
#pragma unroll
    for (int i = 0; i < 8; ++i) v[i] = *(const f32x4*)(src + (size_t)i * N);
#pragma unroll
    for (int j = 0; j < 4; ++j) { const int n = n0 + 4 * nc + j; const int drow = gu == 0 ? n : (((n >> 7) << 8) + (gu - 1) * 128 + (n & 127));
        u32x4 w; w.x = cvt_pk_bf16(v[0][j], v[1][j]); w.y = cvt_pk_bf16(v[2][j], v[3][j]); w.z = cvt_pk_bf16(v[4][j], v[5][j]); w.w = cvt_pk_bf16(v[6][j], v[7][j]);
        *(u32x4*)(WT + (size_t)drow * K + k0 + 8 * kc) = w; }
}

__device__ __forceinline__ void phase_prologue(Frame& F) {
    if (blockIdx.x == 0) {
        f32x2* T128 = (f32x2*)(F.ws + WS_ROPE); f32x2* T64 = (f32x2*)(F.ws + WS_ROPE + 16384);
        for (int i = F.tid; i < 64 * 32; i += NTHREADS) { const int pos = i >> 5, j = i & 31; const float fr = powf(10000.0f, -(float)j / 32.0f); float s, c; sincosf((float)pos * fr, &s, &c); T128[i] = (f32x2){c, s}; }
        for (int i = F.tid; i < 64 * 16; i += NTHREADS) { const int pos = i >> 4, j = i & 15; const float fr = powf(10000.0f, -(float)j / 16.0f); float s, c; sincosf((float)pos * fr, &s, &c); T64[i] = (f32x2){c, s}; }
    }
    {
        LAS float* sact = (LAS float*)F.lds;
        for (int i = F.tid; i < 5 * D; i += NTHREADS) { const int cd = i / D, k = i - cd * D; const float v = cd < 4 ? F.in[I_C][cd * D + k] : F.in[I_CCTX][k]; sact[i] = v * sigmoid_f(v); }
        __syncthreads();
        unsigned long long* mod = (unsigned long long*)(F.ws + WS_MOD);
        for (int t = F.gw; t < 2 * 48 * 16; t += F.NGW) {
            const int l = t / (48 * 16), r = t - l * 48 * 16, jc = r >> 4, ks = r & 15;
            const float* w = F.in[I_ADAW] + ((size_t)l * D + (size_t)ks * 128) * ADA + jc * 256 + 4 * F.lane;
            f32x4 a[5];
#pragma unroll
            for (int cd = 0; cd < 5; ++cd) a[cd] = (f32x4){0.f, 0.f, 0.f, 0.f};
#pragma unroll 4
            for (int k = 0; k < 128; ++k) { const f32x4 wv = *(const f32x4*)(w + (size_t)k * ADA);
#pragma unroll
                for (int cd = 0; cd < 5; ++cd) a[cd] += sact[cd * D + ks * 128 + k] * wv; }
            if (ks == 0) { const f32x4 bv = *(const f32x4*)(F.in[I_ADAB] + (size_t)l * ADA + jc * 256 + 4 * F.lane);
#pragma unroll
                for (int cd = 0; cd < 5; ++cd) a[cd] += bv; }
#pragma unroll
            for (int cd = 0; cd < 5; ++cd) { unsigned long long* dst = mod + ((size_t)l * 5 + cd) * ADA + jc * 256 + 4 * F.lane;
#pragma unroll
                for (int j = 0; j < 4; ++j) atomicAdd(dst + j, (unsigned long long)(long long)(a[cd][j] * MOD_SCALE)); }
        }
        __syncthreads();
    }
    {
        constexpr int I_IN = 32 * 416, I_SQ = 32 * 64, I_F = 32 * 176, I_DN = 88 * 64;
        constexpr int PER_L = I_IN + 2 * I_SQ, N_DENSE = 3 * I_F, N_MOE = 24 * I_F, NITEMS = 2 * PER_L + N_DENSE + N_MOE;
        static_assert(I_F == I_DN, "gate/up/down item counts match");
        for (int it = F.gw; it < NITEMS; it += F.NGW) {
            int r = it;
            if (r < 2 * PER_L) { const int l = r / PER_L; r -= l * PER_L;
                if (r < I_IN) { cvt_item(F.in[I_WIN] + (size_t)l * D * INCOLS, D, INCOLS, (bf16_t*)(F.ws + WS_WIN + (size_t)l * 52 * MiB), 0, r, F.lane); continue; } r -= I_IN;
                if (r < I_SQ) { cvt_item(F.in[I_WBR] + (size_t)l * D * D, D, D, (bf16_t*)(F.ws + WS_WBR + (size_t)l * 8 * MiB), 0, r, F.lane); continue; } r -= I_SQ;
                cvt_item(F.in[I_WOUT] + (size_t)l * D * D, D, D, (bf16_t*)(F.ws + WS_WOUT + (size_t)l * 8 * MiB), 0, r, F.lane); continue; }
            r -= 2 * PER_L;
            if (r < N_DENSE) { const int k = r / I_F; r -= k * I_F;
                if (k == 0) cvt_item(F.in[I_FG], D, DFF, (bf16_t*)(F.ws + WS_WGU0), 1, r, F.lane);
                else if (k == 1) cvt_item(F.in[I_FU], D, DFF, (bf16_t*)(F.ws + WS_WGU0), 2, r, F.lane);
                else cvt_item(F.in[I_FD], DFF, D, (bf16_t*)(F.ws + WS_WD0), 0, r, F.lane);
                continue; }
            r -= N_DENSE;
            { const int q = r / I_F; r -= q * I_F; const int e = q / 3, k = q - e * 3;
                if (k == 0) cvt_item(F.in[I_MG] + (size_t)e * D * DFF, D, DFF, (bf16_t*)(F.ws + WS_WGUM + (size_t)e * 44 * MiB), 1, r, F.lane);
                else if (k == 1) cvt_item(F.in[I_MU] + (size_t)e * D * DFF, D, DFF, (bf16_t*)(F.ws + WS_WGUM + (size_t)e * 44 * MiB), 2, r, F.lane);
                else cvt_item(F.in[I_MD] + (size_t)e * DFF * D, DFF, D, (bf16_t*)(F.ws + WS_WDM + (size_t)e * 22 * MiB), 0, r, F.lane); }
        }
    }
}

__device__ __forceinline__ void norm_mod_row(const float* xrow, const float* g, const modacc_t* sh, const modacc_t* sc, bf16_t* hrow, int lane, f32x4 (&v)[8]) {
    float s = 0.f;
#pragma unroll
    for (int j = 0; j < 8; ++j) { v[j] = *(const f32x4*)(xrow + 4 * lane + 256 * j); s += (v[j][0] * v[j][0] + v[j][1] * v[j][1]) + (v[j][2] * v[j][2] + v[j][3] * v[j][3]); }
    const float rstd = 1.0f / sqrtf(wave_sum(s) * (1.0f / D) + NORM_EPS);
#pragma unroll
    for (int j = 0; j < 8; ++j) { const int c = 4 * lane + 256 * j; const f32x4 gg = *(const f32x4*)(g + c), sv = mod4(sh + c), cv = mod4(sc + c);
        v[j] = (v[j] * rstd * gg) * (1.0f + cv) + sv;
        u32x2 w; w.x = cvt_pk_bf16(v[j][0], v[j][1]); w.y = cvt_pk_bf16(v[j][2], v[j][3]); *(u32x2*)(hrow + c) = w; }
}
__device__ __forceinline__ void phase_norm(Frame& F, const float* src, const float* g, int layer, int chunk_sh, int chunk_sc, bool lat_only) {
    const modacc_t* mod = (const modacc_t*)(F.ws + WS_MOD) + (size_t)layer * 5 * ADA; bf16_t* H = (bf16_t*)(F.ws + WS_H);
    for (int r = F.gw; r < MROWS; r += F.NGW) {
        if (lat_only && (r % RPB) < CTXL) continue;
        const int cd = cond_of_row(r); const float* xr = src ? src + (size_t)r * D : x0_row(F.in[I_X], F.in[I_CTX], r);
        f32x4 v[8]; norm_mod_row(xr, g, mod + (size_t)cd * ADA + chunk_sh * D, mod + (size_t)cd * ADA + chunk_sc * D, H + (size_t)r * D, F.lane, v);
    }
}
__device__ __forceinline__ void phase_prep(Frame& F, int layer) {
    bf16_t* QKV = (bf16_t*)(F.ws + WS_QKV); const f32x2* T128 = (const f32x2*)(F.ws + WS_ROPE); const f32x2* T64 = (const f32x2*)(F.ws + WS_ROPE + 16384);
    const float* qkg = F.in[I_QKG] + (size_t)layer * 256;
    const int sub = F.lane & 7, grp = F.lane >> 3; const long NIT = (long)MROWS * 20;
    for (long base = (long)F.gw * 8; base < NIT; base += (long)F.NGW * 8) {
        const long it = base + grp; const int r = (int)(it / 20), ch = (int)(it - (long)r * 20);
        int col, kind; if (ch < 6) { col = C_GQ + ch * 128; kind = 0; } else if (ch < 14) { col = C_DQ + (ch - 6) * 128; kind = 1; } else { col = C_SQ + (ch - 14) * 128; kind = 2; }
        const int rr = r % RPB; const bool lat = rr >= CTXL; const int n = rr - CTXL, prow = n >> 6, pcol = n & 63;
        bf16_t* p = QKV + (size_t)r * LDQ + col;
        int o1, o2, j0, pos; const f32x2* tab;
        if (kind == 1) { const int mp = sub >> 2, seg = (sub >> 1) & 1; j0 = (sub & 1) * 8; o1 = mp * 64 + seg * 32 + j0; o2 = o1 + 16; pos = seg ? pcol : prow; tab = T64 + pos * 16 + j0; }
        else { const int seg = sub >> 2; j0 = (sub & 3) * 8; o1 = seg * 64 + j0; o2 = o1 + 32; pos = seg ? pcol : prow; tab = T128 + pos * 32 + j0; }
        if (kind != 0 && !lat) continue;
        const u32x4 w1 = *(const u32x4*)(p + o1), w2 = *(const u32x4*)(p + o2);
        float a[8] = {bflo(w1.x), bfhi(w1.x), bflo(w1.y), bfhi(w1.y), bflo(w1.z), bfhi(w1.z), bflo(w1.w), bfhi(w1.w)};
        float b[8] = {bflo(w2.x), bfhi(w2.x), bflo(w2.y), bfhi(w2.y), bflo(w2.z), bfhi(w2.z), bflo(w2.w), bfhi(w2.w)};
        if (kind == 0) {
            float s = 0.f;
#pragma unroll
            for (int j = 0; j < 8; ++j) s += a[j] * a[j] + b[j] * b[j];
            s += __shfl_xor(s, 1); s += __shfl_xor(s, 2); s += __shfl_xor(s, 4);
            const float rstd = 1.0f / sqrtf(s * (1.0f / 128.0f) + NORM_EPS); const float* gq = qkg + (ch < 4 ? 0 : 128);
#pragma unroll
            for (int j = 0; j < 8; ++j) { a[j] = a[j] * rstd * gq[o1 + j]; b[j] = b[j] * rstd * gq[o2 + j]; }
        }
        if (lat) {
#pragma unroll
            for (int j = 0; j < 8; ++j) { const f32x2 cs = tab[j]; const float x1 = a[j], x2 = b[j]; a[j] = x1 * cs.x - x2 * cs.y; b[j] = x1 * cs.y + x2 * cs.x; }
        }
        u32x4 q1, q2; q1.x = cvt_pk_bf16(a[0], a[1]); q1.y = cvt_pk_bf16(a[2], a[3]); q1.z = cvt_pk_bf16(a[4], a[5]); q1.w = cvt_pk_bf16(a[6], a[7]);
        q2.x = cvt_pk_bf16(b[0], b[1]); q2.y = cvt_pk_bf16(b[2], b[3]); q2.z = cvt_pk_bf16(b[4], b[5]); q2.w = cvt_pk_bf16(b[6], b[7]);
        *(u32x4*)(p + o1) = q1; *(u32x4*)(p + o2) = q2;
    }
}

template <class KF>
__device__ __forceinline__ void naive_pass(const bf16_t* QKV, int qrow, int qcol, int dqk, int kcol, int vcol, int nkeys, float scale, const KF& kf, bool has_sink, float sinkv,
                                           LAS float* qs, LAS unsigned char* kl, int lane, float (&o)[2]) {
    for (int d = lane; d < dqk; d += 64) qs[d] = bf2f(QKV[(size_t)qrow * LDQ + qcol + d]);
    LDS_WAIT();
    float m = -1e30f, l = 0.f; o[0] = 0.f; o[1] = 0.f;
    const int srow = lane >> 4, sc16 = lane & 15, nchunk16 = dqk >> 3;
    for (int c0 = 0; c0 < nkeys; c0 += 64) {
        const int i = c0 + lane; const bool valid = i < nkeys; int row = 0; float bias = 0.f;
        if (valid) kf(i, row, bias);
#pragma unroll 4
        for (int g = 0; g < 16; ++g) { const int rr = g * 4 + srow; const int grow = __shfl(row, rr);
            if (sc16 < nchunk16) *(LAS u32x4*)(kl + rr * 272 + sc16 * 16) = *(const u32x4*)(QKV + (size_t)grow * LDQ + kcol + sc16 * 8); }
        LDS_WAIT();
        float s = -1e30f;
        if (valid) { float dsum = 0.f;
            for (int d = 0; d < dqk; d += 8) { const u32x4 w = *(const LAS u32x4*)(kl + lane * 272 + d * 2); const f32x4 q0 = *(const LAS f32x4*)(qs + d), q1 = *(const LAS f32x4*)(qs + d + 4);
                dsum += bflo(w.x) * q0[0] + bfhi(w.x) * q0[1] + bflo(w.y) * q0[2] + bfhi(w.y) * q0[3] + bflo(w.z) * q1[0] + bfhi(w.z) * q1[1] + bflo(w.w) * q1[2] + bfhi(w.w) * q1[3]; }
            s = dsum * scale + bias; }
        LDS_WAIT();
        const float mn = fmaxf(m, wave_max(s)); const float alpha = __expf(m - mn); const float p = valid ? __expf(s - mn) : 0.f;
        l = l * alpha + wave_sum(p); o[0] *= alpha; o[1] *= alpha; m = mn;
#pragma unroll 8
        for (int k = 0; k < 64; ++k) { const float pk = __shfl(p, k); const int rk = __shfl(row, k);
            const unsigned w = *(const unsigned*)(QKV + (size_t)rk * LDQ + vcol + 2 * lane); o[0] += pk * bflo(w); o[1] += pk * bfhi(w); }
    }
    if (has_sink) l += __expf(sinkv - m);
    const float il = 1.0f / l; o[0] *= il; o[1] *= il;
}
__device__ __forceinline__ void phase_attn_naive(Frame& F, int layer, bool need_ctx) {
    const bf16_t* QKV = (const bf16_t*)(F.ws + WS_QKV); bf16_t* O = (bf16_t*)(F.ws + WS_O);
    LAS float* qs = (LAS float*)(F.lds + 8 * 17408) + F.wave * 128; LAS unsigned char* kl = F.lds + F.wave * 17408;
    const float* rpb = F.in[I_RPB] + (size_t)layer * 4 * 15 * 31; const float* sink = F.in[I_SINK] + layer * 4;
    const float* lp = F.in[I_DLAM] + layer * 256; const float* subg = F.in[I_DSUB] + layer * 128;
    const float lambda_init = 0.8f - 0.6f * expf(-0.3f * (float)layer);
    const float lam = __expf(wave_sum(lp[F.lane] * lp[64 + F.lane])) - __expf(wave_sum(lp[128 + F.lane] * lp[192 + F.lane])) + lambda_init;
    const long NIT = 4L * NB * 4 * RPB; const int lane = F.lane;
    for (long it = F.gw; it < NIT; it += F.NGW) {
        const int q = (int)(it % RPB); long t = it / RPB; const int h = (int)(t & 3); t >>= 2; const int b = (int)(t & 3); const int mixer = (int)(t >> 2);
        const bool isctx = q < CTXL; if (isctx && !need_ctx) continue;
        const int qrow = b * RPB + q, brow = b * RPB, n = q - CTXL; float o[2];
        auto kf_plain = [&](int i, int& row, float& bias) { row = brow + i; bias = 0.f; };
        if (mixer == 0) {
            naive_pass(QKV, qrow, C_GQ + h * 128, 128, C_GK + (h >> 1) * 128, C_GV + (h >> 1) * 128, isctx ? CTXL : RPB, 0.08838834764831845f, kf_plain, false, 0.f, qs, kl, lane, o);
        } else if (mixer == 1) {
            float o0[2], o1[2];
            naive_pass(QKV, qrow, C_DQ + h * 128, 64, C_DK + h * 128, C_DV + h * 128, isctx ? CTXL : RPB, 0.125f, kf_plain, false, 0.f, qs, kl, lane, o0);
            naive_pass(QKV, qrow, C_DQ + h * 128 + 64, 64, C_DK + h * 128 + 64, C_DV + h * 128, isctx ? CTXL : RPB, 0.125f, kf_plain, false, 0.f, qs, kl, lane, o1);
            o[0] = o0[0] - lam * o1[0]; o[1] = o0[1] - lam * o1[1];
            const float ms = wave_sum(o[0] * o[0] + o[1] * o[1]) * (1.0f / 128.0f); const float rstd = 1.0f / sqrtf(ms + NORM_EPS);
            o[0] = o[0] * rstd * subg[2 * lane] * (1.0f - lambda_init); o[1] = o[1] * rstd * subg[2 * lane + 1] * (1.0f - lambda_init);
        } else if (mixer == 2) {
            if (isctx) naive_pass(QKV, qrow, C_NQ + h * 128, 128, C_NK + h * 128, C_NV + h * 128, CTXL, 0.08838834764831845f, kf_plain, false, 0.f, qs, kl, lane, o);
            else {
                const int r = n >> 6, qc = n & 63; int rs = r - 4; rs = rs < 0 ? 0 : (rs > 56 ? 56 : rs); int cs = qc - 8; cs = cs < 0 ? 0 : (cs > 48 ? 48 : cs);
                const float* rp = rpb + h * 15 * 31;
                auto kf = [&](int i, int& row, float& bias) { if (i < CTXL) { row = brow + i; bias = 0.f; } else { const int ii = i - CTXL, kr = rs + (ii >> 4), kc = cs + (ii & 15);
                    row = brow + CTXL + kr * 64 + kc; bias = rp[(kr - r + 7) * 31 + (kc - qc + 15)]; } };
                naive_pass(QKV, qrow, C_NQ + h * 128, 128, C_NK + h * 128, C_NV + h * 128, CTXL + 128, 0.08838834764831845f, kf, false, 0.f, qs, kl, lane, o);
            }
        } else {
            if (isctx) naive_pass(QKV, qrow, C_SQ + h * 128, 128, C_SK + (h >> 1) * 128, C_SV + (h >> 1) * 128, CTXL, 0.08838834764831845f, kf_plain, true, sink[h], qs, kl, lane, o);
            else {
                const int lo = n - 128 < 0 ? 0 : n - 128, hi = n + 128 > SEQ - 1 ? SEQ - 1 : n + 128;
                auto kf = [&](int i, int& row, float& bias) { row = i < CTXL ? brow + i : brow + CTXL + lo + (i - CTXL); bias = 0.f; };
                naive_pass(QKV, qrow, C_SQ + h * 128, 128, C_SK + (h >> 1) * 128, C_SV + (h >> 1) * 128, CTXL + (hi - lo + 1), 0.08838834764831845f, kf, true, sink[h], qs, kl, lane, o);
            }
        }
        *(unsigned*)(O + (size_t)qrow * D + mixer * 512 + h * 128 + 2 * lane) = cvt_pk_bf16(o[0], o[1]);
    }
}

namespace fa {
typedef float f32x16 __attribute__((ext_vector_type(16)));
typedef short s16x4 __attribute__((ext_vector_type(4)));
constexpr int SHM_V = 16384, SHM_K = 16384;
constexpr int OFF_WS = 65536, OFF_RPB = 69632, OFF_STG = 77824;
#define FA_KSWZ(row, colB) ((row) * 256 + ((colB) ^ (((row) & 7) << 4)))
#define FA_SBAR() __builtin_amdgcn_sched_barrier(0)
__device__ __forceinline__ int crow(int r, int hi) { return (r & 3) + 8 * (r >> 2) + 4 * hi; }
template <int DQK> struct Sc { static constexpr float SCALE = DQK == 128 ? 0.088388347648318440f : 0.125f; static constexpr float C = SCALE * 1.4426950408889634f; static constexpr float THRS = 8.0f / SCALE; };
template <int DQK>
__device__ __forceinline__ void partialSM(f32x16& p0, f32x16& p1, float& m_reg, float& mn, float& alpha) {
    constexpr float C = Sc<DQK>::C;
    float pmax = p0[0];
#pragma unroll
    for (int r = 1; r < 16; ++r) pmax = fmaxf(pmax, p0[r]);
#pragma unroll
    for (int r = 0; r < 16; ++r) pmax = fmaxf(pmax, p1[r]);
    { auto rr = __builtin_amdgcn_permlane32_swap(__float_as_uint(pmax), __float_as_uint(pmax), false, false);
      pmax = fmaxf(__uint_as_float(rr[0]), __uint_as_float(rr[1])); }
    if (__builtin_expect(__all(pmax - m_reg <= Sc<DQK>::THRS), 1)) { mn = m_reg; alpha = 1.f; }
    else { mn = fmaxf(m_reg, pmax); alpha = __builtin_amdgcn_exp2f((m_reg - mn) * C); m_reg = mn; }
    const float mnC = -mn * C;
#pragma unroll
    for (int r = 0; r < 16; ++r) p0[r] = fmaf(p0[r], C, mnC);
#pragma unroll
    for (int r = 0; r < 16; ++r) p1[r] = fmaf(p1[r], C, mnC);
#pragma unroll
    for (int r = 0; r < 16; ++r) p0[r] = __builtin_amdgcn_exp2f(p0[r]);
}
__device__ __forceinline__ void finishSM(f32x16& p0, f32x16& p1, float alpha, float& l_reg, bf16x8& pa0, bf16x8& pa1, bf16x8& pa2, bf16x8& pa3) {
#pragma unroll
    for (int r = 0; r < 16; ++r) p1[r] = __builtin_amdgcn_exp2f(p1[r]);
    float ps = 0;
#pragma unroll
    for (int r = 0; r < 16; ++r) ps += p0[r];
#pragma unroll
    for (int r = 0; r < 16; ++r) ps += p1[r];
    { auto rr = __builtin_amdgcn_permlane32_swap(__float_as_uint(ps), __float_as_uint(ps), false, false);
      ps = __uint_as_float(rr[0]) + __uint_as_float(rr[1]); }
    l_reg = l_reg * alpha + ps;
#define FA_PK4(P, BASE, OUT) do { unsigned a0 = cvt_pk_bf16(P[BASE + 0], P[BASE + 1]), a1 = cvt_pk_bf16(P[BASE + 2], P[BASE + 3]);   \
    unsigned b0 = cvt_pk_bf16(P[BASE + 4], P[BASE + 5]), b1 = cvt_pk_bf16(P[BASE + 6], P[BASE + 7]);                              \
    auto r0 = __builtin_amdgcn_permlane32_swap(a0, b0, false, false); auto r1 = __builtin_amdgcn_permlane32_swap(a1, b1, false, false); \
    u32x4 w = {r0[0], r1[0], r0[1], r1[1]}; OUT = __builtin_bit_cast(bf16x8, w); } while (0)
    FA_PK4(p0, 0, pa0); FA_PK4(p0, 8, pa1); FA_PK4(p1, 0, pa2); FA_PK4(p1, 8, pa3);
#undef FA_PK4
}
template <int DQK, bool QL>
__device__ __forceinline__ void qkt(f32x16& p0, f32x16& p1, const LAS char* Ks, const bf16x8* qr, const LAS char* qlds, int r32, int hi, int kloff) {
    p0 = (f32x16){}; p1 = (f32x16){};
#pragma unroll
    for (int d0 = 0; d0 < DQK / 16; ++d0) { const int cb = kloff + (d0 * 16 + hi * 8) * 2;
        bf16x8 qf; if constexpr (QL) qf = *(const LAS bf16x8*)(qlds + d0 * 1024); else qf = qr[d0];
        const bf16x8 b0 = *(const LAS bf16x8*)(Ks + FA_KSWZ(r32, cb));
        const bf16x8 b1 = *(const LAS bf16x8*)(Ks + FA_KSWZ(32 + r32, cb));
        p0 = __builtin_amdgcn_mfma_f32_32x32x16_bf16(b0, qf, p0, 0, 0, 0);
        p1 = __builtin_amdgcn_mfma_f32_32x32x16_bf16(b1, qf, p1, 0, 0, 0); }
}
__device__ __forceinline__ int v_st(int k, int c) { const int kk = (k & ~0xC) | ((k & 4) << 1) | ((k & 8) >> 1); return ((kk >> 3) * 4 + (c >> 5)) * 512 + ((kk & 7) * 32 + (c & 31)) * 2; }
__device__ __forceinline__ int v_rd_base(int lane) { return ((lane & 3) << 3) | (((lane >> 2) & 3) << 6) | (((lane >> 4) & 1) << 5) | (((lane >> 5) & 1) << 8); }
constexpr int v_rd_off(int d0, int ks, int half) { return d0 * 512 + ks * 4096 + half * 2048; }
template <int OFF> __device__ __forceinline__ s16x4 tr_read(int vb) {
    s16x4 r; asm volatile("ds_read_b64_tr_b16 %0, %1 offset:%2" : "=&v"(r) : "v"(vb), "i"(OFF) : "memory"); return r;
}
template <int D0> __device__ __forceinline__ void pv_one(f32x16& od, int vb, bf16x8 pa0, bf16x8 pa1, bf16x8 pa2, bf16x8 pa3) {
    const s16x4 l0 = tr_read<v_rd_off(D0, 0, 0)>(vb), h0 = tr_read<v_rd_off(D0, 0, 1)>(vb), l1 = tr_read<v_rd_off(D0, 1, 0)>(vb), h1 = tr_read<v_rd_off(D0, 1, 1)>(vb);
    const s16x4 l2 = tr_read<v_rd_off(D0, 2, 0)>(vb), h2 = tr_read<v_rd_off(D0, 2, 1)>(vb), l3 = tr_read<v_rd_off(D0, 3, 0)>(vb), h3 = tr_read<v_rd_off(D0, 3, 1)>(vb);
    asm volatile("s_waitcnt lgkmcnt(0)" ::: "memory"); FA_SBAR();
#define FA_PK(L, H) (bf16x8){L[0], L[1], L[2], L[3], H[0], H[1], H[2], H[3]}
    od = __builtin_amdgcn_mfma_f32_32x32x16_bf16(pa0, FA_PK(l0, h0), od, 0, 0, 0);
    od = __builtin_amdgcn_mfma_f32_32x32x16_bf16(pa1, FA_PK(l1, h1), od, 0, 0, 0);
    od = __builtin_amdgcn_mfma_f32_32x32x16_bf16(pa2, FA_PK(l2, h2), od, 0, 0, 0);
    od = __builtin_amdgcn_mfma_f32_32x32x16_bf16(pa3, FA_PK(l3, h3), od, 0, 0, 0);
#undef FA_PK
}
__device__ __forceinline__ void pv_d0(f32x16* o, int vb, bf16x8 pa0, bf16x8 pa1, bf16x8 pa2, bf16x8 pa3) {
    pv_one<0>(o[0], vb, pa0, pa1, pa2, pa3); pv_one<1>(o[1], vb, pa0, pa1, pa2, pa3); pv_one<2>(o[2], vb, pa0, pa1, pa2, pa3); pv_one<3>(o[3], vb, pa0, pa1, pa2, pa3);
}
template <int DQK, int SD, bool QL, class MaskFn>
__device__ __forceinline__ void attn_core(const bf16_t* __restrict__ QKV, const int qrow, const int qcol, const int kcol, const int vcol, const int kloff,
                                          const int NT, const int brow, const int bb, const int nb, const MaskFn& maskf, LAS char* lds, f32x16 (&o)[4], float& m_reg, float& l_reg) {
    const int tid = threadIdx.x, wid = tid >> 6, lane = tid & 63, r32 = lane & 31, hi = lane >> 5;
    LAS char* V_lds = lds; LAS char* K_lds = lds + 2 * SHM_V;
    LAS float* al_l = (LAS float*)(lds + OFF_WS) + wid * 64 + 32;
    m_reg = -1e30f; l_reg = 0.f;
#pragma unroll
    for (int d = 0; d < 4; ++d) o[d] = (f32x16){};
    bf16x8 qr[QL ? 1 : DQK / 16];
    LAS char* qlds = lds + OFF_STG + wid * 8192 + lane * 16;
    { int lq = lane; asm volatile("" : "+v"(lq));
      const bf16_t* Qw = QKV + (size_t)(qrow + (lq & 31)) * LDQ + qcol + (lq >> 5) * 8;
#pragma unroll
      for (int d0 = 0; d0 < DQK / 16; ++d0) { const bf16x8 q = *(const bf16x8*)(Qw + d0 * 16); if constexpr (QL) *(LAS bf16x8*)(qlds + d0 * 1024) = q; else qr[d0] = q; } }
    const int sr = tid >> 4, sc = (tid & 15) * 8, vst0 = v_st(sr, sc), vst1 = v_st(32 + sr, sc);
    const int vb0 = (int)(unsigned)(__SIZE_TYPE__)V_lds + v_rd_base(lane);
    struct { bf16x8 vs0, vs1, ks0, ks1; } sr_[SD];
    constexpr int SE = 0, SO = SD - 1;
#define FA_TROW(j) ((j) < 4 ? brow + 64 * (j) : bb + 64 * (((j) - 4) < nb ? ((j) - 4) : nb - 1))
#define FA_SLOAD(i, j) do { const bf16_t* rp_ = QKV + (size_t)(FA_TROW(j) + sr) * LDQ + sc; \
    sr_[i].vs0 = *(const bf16x8*)(rp_ + vcol); sr_[i].vs1 = *(const bf16x8*)(rp_ + 32 * LDQ + vcol); \
    sr_[i].ks0 = *(const bf16x8*)(rp_ + kcol); sr_[i].ks1 = *(const bf16x8*)(rp_ + 32 * LDQ + kcol); } while (0)
#define FA_SWRITE(b, i) do { *(LAS bf16x8*)(V_lds + (b) * SHM_V + vst0) = sr_[i].vs0; *(LAS bf16x8*)(V_lds + (b) * SHM_V + vst1) = sr_[i].vs1; const int kc_ = sc * 2; \
    *(LAS bf16x8*)(K_lds + (b) * SHM_K + FA_KSWZ(sr, kc_)) = sr_[i].ks0; *(LAS bf16x8*)(K_lds + (b) * SHM_K + FA_KSWZ(32 + sr, kc_)) = sr_[i].ks1; } while (0)
#define FA_SWAIT() do { if constexpr (SD == 2) asm volatile("s_waitcnt vmcnt(4)" ::: "memory"); else asm volatile("s_waitcnt vmcnt(0)" ::: "memory"); } while (0)
#define FA_RESC(a) do { if (__any((a) < 1.f)) { if (hi == 0) al_l[r32] = (a); asm volatile("s_waitcnt lgkmcnt(0)" ::: "memory"); \
    _Pragma("unroll") for (int d = 0; d < 4; ++d) _Pragma("unroll") for (int r = 0; r < 16; ++r) o[d][r] *= al_l[crow(r, hi)]; } } while (0)
    f32x16 pA0, pA1, pB0, pB1; float mnA, mnB, alA, alB; bf16x8 pa0, pa1, pa2, pa3;
    FA_SLOAD(SE, 0); asm volatile("s_waitcnt vmcnt(0)" ::: "memory"); FA_SWRITE(0, SE); __syncthreads();
    qkt<DQK, QL>(pA0, pA1, K_lds, qr, qlds, r32, hi, kloff); maskf(pA0, pA1, 0); partialSM<DQK>(pA0, pA1, m_reg, mnA, alA);
    FA_SLOAD(SO, 1); if constexpr (SD == 2) { if (2 < NT) FA_SLOAD(SE, 2); }
    FA_SWAIT(); FA_SWRITE(1, SO); __syncthreads();
    for (int j = 1; j + 1 < NT; j += 2) {
        FA_SBAR(); qkt<DQK, QL>(pB0, pB1, K_lds + SHM_K, qr, qlds, r32, hi, kloff);
        finishSM(pA0, pA1, alA, l_reg, pa0, pa1, pa2, pa3); FA_SBAR();
        FA_SLOAD(SO, j + SD); FA_SBAR();
        pv_d0(o, vb0, pa0, pa1, pa2, pa3); maskf(pB0, pB1, j); partialSM<DQK>(pB0, pB1, m_reg, mnB, alB);
        __syncthreads(); FA_SWAIT(); FA_SWRITE(0, SE);
        FA_RESC(alB); __syncthreads();
        FA_SBAR(); qkt<DQK, QL>(pA0, pA1, K_lds, qr, qlds, r32, hi, kloff);
        finishSM(pB0, pB1, alB, l_reg, pa0, pa1, pa2, pa3); FA_SBAR();
        if (SD == 1 || j + 3 < NT) FA_SLOAD(SE, j + 1 + SD); FA_SBAR();
        pv_d0(o, vb0 + SHM_V, pa0, pa1, pa2, pa3); maskf(pA0, pA1, j + 1); partialSM<DQK>(pA0, pA1, m_reg, mnA, alA);
        __syncthreads(); FA_SWAIT(); FA_SWRITE(1, SO);
        FA_RESC(alA); __syncthreads();
    }
    FA_SBAR(); qkt<DQK, QL>(pB0, pB1, K_lds + SHM_K, qr, qlds, r32, hi, kloff);
    finishSM(pA0, pA1, alA, l_reg, pa0, pa1, pa2, pa3); FA_SBAR();
    pv_d0(o, vb0, pa0, pa1, pa2, pa3); maskf(pB0, pB1, NT - 1); partialSM<DQK>(pB0, pB1, m_reg, mnB, alB);
    __syncthreads(); FA_RESC(alB);
    finishSM(pB0, pB1, alB, l_reg, pa0, pa1, pa2, pa3); FA_SBAR();
    pv_d0(o, vb0 + SHM_V, pa0, pa1, pa2, pa3);
#undef FA_TROW
#undef FA_SLOAD
#undef FA_SWRITE
#undef FA_SWAIT
#undef FA_RESC
}
__device__ __forceinline__ void normalize_o(f32x16 (&o)[4], float l_reg, LAS char* lds, int wid, int lane_in) {
    int lane = lane_in; asm volatile("" : "+v"(lane));
    const int r32 = lane & 31, hi = lane >> 5;
    LAS float* li_l = (LAS float*)(lds + OFF_WS) + wid * 64;
    if (hi == 0) li_l[r32] = l_reg; asm volatile("s_waitcnt lgkmcnt(0)" ::: "memory");
#pragma unroll
    for (int r = 0; r < 16; ++r) { const float rl = __builtin_amdgcn_rcpf(li_l[crow(r, hi)]);
#pragma unroll
        for (int d = 0; d < 4; ++d) o[d][r] *= rl; }
}
__device__ __forceinline__ void store_o(const f32x16 (&o)[4], bf16_t* Orow0, LAS char* lds, int wid, int lane_in) {
    int lane = lane_in; asm volatile("" : "+v"(lane));
    const int r32 = lane & 31, hi = lane >> 5;
    LAS char* stg = lds + OFF_STG + wid * 8192;
#pragma unroll
    for (int d = 0; d < 4; ++d)
#pragma unroll
        for (int r = 0; r < 16; ++r) *(LAS bf16_t*)(stg + crow(r, hi) * 256 + (32 * d + r32) * 2) = (bf16_t)(cvt_pk_bf16(o[d][r], 0.f) & 0xffffu);
    asm volatile("s_waitcnt lgkmcnt(0)" ::: "memory");
#pragma unroll
    for (int i = 0; i < 8; ++i) { const int id = i * 64 + lane, row = id >> 4, c16 = id & 15;
        *(u32x4*)(Orow0 + (size_t)row * D + c16 * 8) = *(const LAS u32x4*)(stg + row * 256 + c16 * 16); }
    asm volatile("s_waitcnt lgkmcnt(0)" ::: "memory");
}
}

template <bool MASKED>
__device__ __forceinline__ void attn_unit_std(Frame& F, int layer, int kind, int b, int h, int qb) {
    const bf16_t* QKV = (const bf16_t*)(F.ws + WS_QKV); bf16_t* O = (bf16_t*)(F.ws + WS_O);
    LAS char* lds = (LAS char*)F.lds; const int w = F.wave, lane = F.lane, r32 = lane & 31, hi = lane >> 5;
    const int brow = b * RPB; const bool isctx = qb < 0; const int q0 = isctx ? brow : brow + CTXL + qb * 256;
    const int kvh = h >> 1;
    const int qcol = kind == 0 ? C_GQ + h * 128 : (kind == 2 ? C_NQ + h * 128 : C_SQ + h * 128);
    const int kcol = kind == 0 ? C_GK + kvh * 128 : (kind == 2 ? C_NK + h * 128 : C_SK + kvh * 128);
    const int vcol = kind == 0 ? C_GV + kvh * 128 : (kind == 2 ? C_NV + h * 128 : C_SV + kvh * 128);
    int NT = 4, bb = brow, nb = 1, ks = 0, krs = 0;
    if (!isctx) {
        if (kind == 0) { NT = 68; bb = brow + CTXL; nb = 64; }
        else if (kind == 3) { ks = 256 * qb - 128; ks = ks < 0 ? 0 : ks; int ke = 256 * qb + 384; ke = ke > SEQ ? SEQ : ke; nb = (ke - ks) >> 6; NT = 4 + nb; bb = brow + CTXL + ks; }
        else { const int r0 = 4 * qb; krs = r0 - 4; krs = krs < 0 ? 0 : (krs > 56 ? 56 : krs); int kre = r0 - 1; kre = kre < 0 ? 0 : (kre > 56 ? 56 : kre); kre += 7; nb = kre - krs + 1; NT = 4 + nb + (nb & 1); bb = brow + CTXL + 64 * krs; }
    }
    const int qn0 = 256 * qb + 32 * w;
    const int gr = 4 * qb + (w >> 1); int rs_w = gr - 4; rs_w = rs_w < 0 ? 0 : (rs_w > 56 ? 56 : rs_w);
    const int qc = (w & 1) * 32 + r32; int cs = qc - 8; cs = cs < 0 ? 0 : (cs > 48 ? 48 : cs);
    if constexpr (MASKED) {
        if (kind == 2) { LAS float* rt = (LAS float*)(lds + fa::OFF_RPB); const float* rpb = F.in[I_RPB] + ((size_t)layer * 4 + h) * 465;
            for (int i = F.tid; i < 465; i += NTHREADS) { const int di = i / 31, dj = i - di * 31; rt[di * 128 + 48 + dj] = rpb[i] * 11.313708498984761f; }
            __syncthreads(); }
    }
    const int mkind = isctx ? 0 : kind;
    const int tb_lane = (int)(unsigned)(__SIZE_TYPE__)(lds + fa::OFF_RPB) + (48 + 15 + 4 * hi - qc) * 4;
    const int vt_lane = 4 * hi - cs;
    auto maskf = [&](fa::f32x16& p0, fa::f32x16& p1, int j) {
        if constexpr (!MASKED) return;
        if (j < 4 || mkind == 0) return;
        const int jb = j - 4;
        if (mkind == 3) {
            const int dq0 = qn0 - ks - 64 * jb;
            if (dq0 + 31 <= 128 && dq0 - 63 >= -128) return;
            const int dql = dq0 + r32 - 4 * hi + 128;
#pragma unroll
            for (int r = 0; r < 16; ++r) { const int cr = (r & 3) + 8 * (r >> 2); int t = dql; asm volatile("" : "+v"(t));
                p0[r] = ((unsigned)(t - cr) <= 256u) ? p0[r] : -1e30f; p1[r] = ((unsigned)(t - cr - 32) <= 256u) ? p1[r] : -1e30f; }
        } else {
            const int kr = krs + jb; const bool wv = (jb < nb) && (kr >= rs_w) && (kr <= rs_w + 7);
            if (!wv) {
#pragma unroll
                for (int r = 0; r < 16; ++r) { p0[r] = -1e30f; p1[r] = -1e30f; }
                return; }
            const int tb = tb_lane + (kr - gr + 7) * 512;
#pragma unroll
            for (int r = 0; r < 16; ++r) { const int cr = (r & 3) + 8 * (r >> 2); int t = vt_lane; asm volatile("" : "+v"(t));
                const float b0 = *(const LAS float*)(__SIZE_TYPE__)(unsigned)(tb + cr * 4), b1 = *(const LAS float*)(__SIZE_TYPE__)(unsigned)(tb + cr * 4 + 128);
                p0[r] = ((unsigned)(t + cr) < 16u) ? p0[r] + b0 : -1e30f; p1[r] = ((unsigned)(t + cr + 32) < 16u) ? p1[r] + b1 : -1e30f; }
        }
    };
    fa::f32x16 o[4]; float m_reg, l_reg;
    if constexpr (MASKED) fa::attn_core<128, 1, true>(QKV, q0 + 32 * w, qcol, kcol, vcol, 0, NT, brow, bb, nb, maskf, lds, o, m_reg, l_reg);
    else fa::attn_core<128, 1, false>(QKV, q0 + 32 * w, qcol, kcol, vcol, 0, NT, brow, bb, nb, maskf, lds, o, m_reg, l_reg);
    if (kind == 3) l_reg += __builtin_amdgcn_exp2f(F.in[I_SINK][layer * 4 + h] * 1.4426950408889634f - m_reg * fa::Sc<128>::C);
    fa::normalize_o(o, l_reg, lds, w, lane);
    fa::store_o(o, O + (size_t)(q0 + 32 * w) * D + (kind == 0 ? 0 : (kind == 2 ? 1024 : 1536)) + h * 128, lds, w, lane);
    __syncthreads();
}
__device__ __forceinline__ void attn_unit_diff(Frame& F, int layer, int b, int h, int qb, float lam, float lambda_init) {
    const bf16_t* QKV = (const bf16_t*)(F.ws + WS_QKV); bf16_t* O = (bf16_t*)(F.ws + WS_O);
    LAS char* lds = (LAS char*)F.lds; const int w = F.wave, lane = F.lane, r32 = lane & 31, hi = lane >> 5, mp = w >> 2, wq = w & 3;
    const int brow = b * RPB; const bool isctx = qb < 0; const int q0 = isctx ? brow + 128 * (-1 - qb) : brow + CTXL + qb * 128;
    const int NT = isctx ? 4 : 68, bb = brow + CTXL, nb = isctx ? 1 : 64;
    auto maskf = [&](fa::f32x16&, fa::f32x16&, int) {};
    fa::f32x16 o[4]; float m_reg, l_reg;
    fa::attn_core<64, 2, false>(QKV, q0 + 32 * wq, C_DQ + h * 128 + 64 * mp, C_DK + h * 128, C_DV + h * 128, 128 * mp, NT, brow, bb, nb, maskf, lds, o, m_reg, l_reg);
    fa::normalize_o(o, l_reg, lds, w, lane);
    __syncthreads();
    LAS float* X = (LAS float*)lds + wq * 4096 + lane;
    if (mp == 1) {
#pragma unroll
        for (int d = 0; d < 4; ++d)
#pragma unroll
            for (int r = 0; r < 16; ++r) X[(d * 16 + r) * 64] = o[d][r];
    }
    asm volatile("s_waitcnt lgkmcnt(0)" ::: "memory");
    __syncthreads();
    if (mp == 0) {
        const float* sg = F.in[I_DSUB] + layer * 128; float g4[4];
#pragma unroll
        for (int d = 0; d < 4; ++d) g4[d] = sg[32 * d + r32] * (1.0f - lambda_init);
#pragma unroll
        for (int r = 0; r < 16; ++r) { float ss = 0.f;
#pragma unroll
            for (int d = 0; d < 4; ++d) { o[d][r] = o[d][r] - lam * X[(d * 16 + r) * 64]; ss += o[d][r] * o[d][r]; }
            ss += __shfl_xor(ss, 1); ss += __shfl_xor(ss, 2); ss += __shfl_xor(ss, 4); ss += __shfl_xor(ss, 8); ss += __shfl_xor(ss, 16);
            const float rstd = 1.0f / sqrtf(ss * (1.0f / 128.0f) + NORM_EPS);
#pragma unroll
            for (int d = 0; d < 4; ++d) o[d][r] = o[d][r] * rstd * g4[d]; }
        fa::store_o(o, O + (size_t)(q0 + 32 * wq) * D + 512 + h * 128, lds, w, lane);
    }
    __syncthreads();
}
__device__ __forceinline__ void phase_attn(Frame& F, int layer, bool need_ctx) {
    LAS char* lds = (LAS char*)F.lds;
    const int G = F.G, c = (int)blockIdx.x;
    const int ndiff = need_ctx ? 544 : 512, nplain = need_ctx ? 304 : 256;
    for (int u = c; u < nplain; u += G) {
        int kind, b, h, qb;
        if (u < 256) { const int x = u & 7, t = u >> 3; kind = 0; b = x >> 1; h = 2 * (x & 1) + (t >> 4); qb = t & 15; }
        else { const int v = u - 256, kd = v >> 4, bh = v & 15; kind = kd == 0 ? 0 : (kd == 1 ? 2 : 3); b = bh >> 2; h = bh & 3; qb = -1; }
#ifndef NO_STD
        attn_unit_std<false>(F, layer, kind, b, h, qb);
#endif
    }
    for (int u = c; u < 512; u += G) {
        const int s = u >> 8, v = u & 255, x = v & 7, t = v >> 3; int b, h;
        if (s == 0) { const int bh = x * 2 + (t >> 4); b = bh >> 2; h = bh & 3; } else { b = x >> 1; h = 2 * (x & 1) + (t >> 4); }
#ifndef NO_MSK
        attn_unit_std<true>(F, layer, s == 0 ? 2 : 3, b, h, t & 15);
#endif
    }
    const float* lp = F.in[I_DLAM] + layer * 256;
    const float lambda_init = layer == 0 ? 0.2f : 0.35550906759096923f;
    const float lam = __expf(wave_sum(lp[F.lane] * lp[64 + F.lane])) - __expf(wave_sum(lp[128 + F.lane] * lp[192 + F.lane])) + lambda_init;
    for (int u = c; u < ndiff; u += G) {
        int b, h, qb;
        if (u < 512) { const int x = u & 7, t = u >> 3, bh = x * 2 + (t >> 5); b = bh >> 2; h = bh & 3; qb = t & 31; }
        else { const int v = u - 512, bh = v >> 1; b = bh >> 2; h = bh & 3; qb = -1 - (v & 1); }
#ifndef NO_DIFF
        attn_unit_diff(F, layer, b, h, qb, lam, lambda_init);
#endif
    }
}

__device__ __forceinline__ void phase_norm_router(Frame& F, const float* X3) {
    LAS float* rt = (LAS float*)F.lds;
    for (int i = F.tid; i < D * NEXP; i += NTHREADS) { const int k = i >> 3, e = i & 7; rt[e * D + k] = F.in[I_ROUTER][i]; }
    __syncthreads();
    const modacc_t* mod = (const modacc_t*)(F.ws + WS_MOD) + (size_t)1 * 5 * ADA; bf16_t* H = (bf16_t*)(F.ws + WS_H);
    int* rt_e = (int*)(F.ws + WS_ROUTE); f32x2* rt_w = (f32x2*)(F.ws + WS_ROUTE + 65536);
    const float* g = F.in[I_FNG] + D;
    unsigned cnt[NEXP];
#pragma unroll
    for (int e = 0; e < NEXP; ++e) cnt[e] = 0u;
    for (int t = F.gw; t < NB * SEQ; t += F.NGW) {
        const int b = t >> 12, n = t & 4095, r = b * RPB + CTXL + n;
        f32x4 v[8]; norm_mod_row(X3 + (size_t)r * D, g, mod + (size_t)b * ADA + 3 * D, mod + (size_t)b * ADA + 4 * D, H + (size_t)r * D, F.lane, v);
        float lg[NEXP];
#pragma unroll
        for (int e = 0; e < NEXP; ++e) { float s = 0.f;
#pragma unroll
            for (int j = 0; j < 8; ++j) { const f32x4 w = *(const LAS f32x4*)(rt + e * D + 4 * F.lane + 256 * j); s += (v[j][0] * w[0] + v[j][1] * w[1]) + (v[j][2] * w[2] + v[j][3] * w[3]); }
            lg[e] = wave_sum(s); }
        float mx = lg[0];
#pragma unroll
        for (int e = 1; e < NEXP; ++e) mx = fmaxf(mx, lg[e]);
        float p[NEXP], ps = 0.f;
#pragma unroll
        for (int e = 0; e < NEXP; ++e) { p[e] = __expf(lg[e] - mx); ps += p[e]; }
        int e1 = 0; float p1 = p[0];
#pragma unroll
        for (int e = 1; e < NEXP; ++e) if (p[e] > p1) { p1 = p[e]; e1 = e; }
        int e2 = -1; float p2 = -1.f;
#pragma unroll
        for (int e = 0; e < NEXP; ++e) if (e != e1 && p[e] > p2) { p2 = p[e]; e2 = e; }
        const float inv = 1.0f / (p1 + p2);
        if (F.lane == 0) { rt_e[t] = e1 | (e2 << 8); rt_w[t] = (f32x2){p1 * inv, p2 * inv}; }
#pragma unroll
        for (int e = 0; e < NEXP; ++e) cnt[e] += (e == e1 || e == e2) ? 1u : 0u;
    }
    if (F.lane == 0) {
#pragma unroll
        for (int e = 0; e < NEXP; ++e) if (cnt[e]) atomicAdd(F.ctl + CW_CNT + e, cnt[e]);
    }
    __syncthreads();
}
__device__ __forceinline__ void moe_offsets(Frame& F, int (&cntv)[NEXP], int (&off)[NEXP + 1]) {
    off[0] = 0;
#pragma unroll
    for (int e = 0; e < NEXP; ++e) { cntv[e] = (int)__hip_atomic_load(F.ctl + CW_CNT + e, __ATOMIC_RELAXED, __HIP_MEMORY_SCOPE_AGENT); off[e + 1] = off[e] + ((cntv[e] + 255) & ~255); }
}
__device__ __forceinline__ void phase_gather(Frame& F) {
    int cntv[NEXP], off[NEXP + 1]; moe_offsets(F, cntv, off);
    const bf16_t* H = (const bf16_t*)(F.ws + WS_H); bf16_t* XS = (bf16_t*)(F.ws + WS_XS);
    const int* rt_e = (const int*)(F.ws + WS_ROUTE); int* rt_pos = (int*)(F.ws + WS_ROUTE + 65536 + 131072);
    for (int t = F.gw; t < NB * SEQ; t += F.NGW) {
        const int b = t >> 12, n = t & 4095, r = b * RPB + CTXL + n; const int ee = rt_e[t], e1 = ee & 255, e2 = ee >> 8;
        int p1 = 0, p2 = 0;
        if (F.lane == 0) { int o1 = 0, o2 = 0;
#pragma unroll
            for (int e = 0; e < NEXP; ++e) { o1 = (e == e1) ? off[e] : o1; o2 = (e == e2) ? off[e] : o2; }
            p1 = o1 + (int)atomicAdd(F.ctl + CW_CUR + e1, 1u); p2 = o2 + (int)atomicAdd(F.ctl + CW_CUR + e2, 1u);
            rt_pos[2 * t] = p1; rt_pos[2 * t + 1] = p2; }
        p1 = __shfl(p1, 0); p2 = __shfl(p2, 0);
        const u32x4* src = (const u32x4*)(H + (size_t)r * D); u32x4* d1 = (u32x4*)(XS + (size_t)p1 * D); u32x4* d2 = (u32x4*)(XS + (size_t)p2 * D);
#pragma unroll
        for (int j = 0; j < 4; ++j) { const u32x4 w = src[F.lane + 64 * j]; d1[F.lane + 64 * j] = w; d2[F.lane + 64 * j] = w; }
    }
#pragma unroll
    for (int e = 0; e < NEXP; ++e) { const int npad = off[e + 1] - off[e] - cntv[e];
        for (int j = F.gw; j < npad; j += F.NGW) { u32x4* d = (u32x4*)(XS + (size_t)(off[e] + cntv[e] + j) * D);
#pragma unroll
            for (int q = 0; q < 4; ++q) d[F.lane + 64 * q] = (u32x4){0u, 0u, 0u, 0u}; } }
}
__device__ __forceinline__ void phase_final(Frame& F, const float* X3, float* out) {
    const modacc_t* mod = (const modacc_t*)(F.ws + WS_MOD) + (size_t)1 * 5 * ADA; const bf16_t* Y2 = (const bf16_t*)(F.ws + WS_Y2);
    const f32x2* rt_w = (const f32x2*)(F.ws + WS_ROUTE + 65536); const int* rt_pos = (const int*)(F.ws + WS_ROUTE + 65536 + 131072);
    const float* fg = F.in[I_FINALG];
    for (int t = F.gw; t < NB * SEQ; t += F.NGW) {
        const int b = t >> 12, n = t & 4095, r = b * RPB + CTXL + n; const f32x2 w = rt_w[t]; const int p1 = rt_pos[2 * t], p2 = rt_pos[2 * t + 1];
        const float* xr = X3 + (size_t)r * D; const modacc_t* gf = mod + (size_t)b * ADA + 5 * D;
        f32x4 z[8]; float s = 0.f;
#pragma unroll
        for (int j = 0; j < 8; ++j) { const int c = 4 * F.lane + 256 * j; const u32x2 a = *(const u32x2*)(Y2 + (size_t)p1 * D + c), bb = *(const u32x2*)(Y2 + (size_t)p2 * D + c);
            const f32x4 ya = {bflo(a.x), bfhi(a.x), bflo(a.y), bfhi(a.y)}, yb = {bflo(bb.x), bfhi(bb.x), bflo(bb.y), bfhi(bb.y)};
            z[j] = *(const f32x4*)(xr + c) + mod4(gf + c) * (w.x * ya + w.y * yb);
            s += (z[j][0] * z[j][0] + z[j][1] * z[j][1]) + (z[j][2] * z[j][2] + z[j][3] * z[j][3]); }
        const float rstd = 1.0f / sqrtf(wave_sum(s) * (1.0f / D) + NORM_EPS);
#pragma unroll
        for (int j = 0; j < 8; ++j) { const int c = 4 * F.lane + 256 * j; *(f32x4*)(out + (size_t)t * D + c) = z[j] * rstd * *(const f32x4*)(fg + c); }
    }
}

#ifndef PH_MASK
#define PH_MASK 0xFFFFFFFFu
#endif
#define IN(k) (((PH_MASK >> (k)) & 1u) && lo <= (k) && (k) < hi)
#define SEAM(k) do { if (IN(k) && IN((k) + 1)) xcd_barrier(bar); } while (0)
template <int LAYER>
__device__ __forceinline__ void layer_common(Frame& F, const XcdBarrier& bar, const int lo, const int hi) {
    constexpr int pb = 1 + 9 * LAYER;
    constexpr bool lat_only = LAYER == 1;
    LAS unsigned char* ring = F.lds; const int cb = (int)blockIdx.x;
    if (IN(pb + 0)) phase_norm(F, LAYER == 0 ? nullptr : (const float*)(F.ws + WS_X2), F.in[I_ANG] + LAYER * D, LAYER, 0, 1, false);
    SEAM(pb + 0);
    if (IN(pb + 1)) {
        SchedGrid S{NPAN, INCOLS / 256, F.G, cb, false, (const char*)(F.ws + WS_H), (const char*)(F.ws + WS_WIN + (size_t)LAYER * 52 * MiB), (size_t)256 * D * 2, (size_t)256 * D * 2};
        EpiInProj E{(bf16_t*)(F.ws + WS_QKV), (bf16_t*)(F.ws + WS_GATES)};
        pg8::gemm_phase<EpiInProj, SchedGrid>(ring, pg8::Dims{D, D, D}, S, E);
    }
    SEAM(pb + 1);
    if (IN(pb + 2)) phase_prep(F, LAYER);
    SEAM(pb + 2);
#ifdef ATTN_NAIVE
    if (IN(pb + 3)) { phase_attn_naive(F, LAYER, LAYER == 0); __syncthreads(); }
#else
    if (IN(pb + 3)) { phase_attn(F, LAYER, LAYER == 0); __syncthreads(); }
#endif
    SEAM(pb + 3);
    if (IN(pb + 4)) {
        SchedMerge S{lat_only ? 64 : NPAN, F.G, cb, lat_only, (const char*)(F.ws + WS_O), (const char*)(F.ws + WS_WBR + (size_t)LAYER * 8 * MiB)};
        EpiMerge E{(const bf16_t*)(F.ws + WS_GATES), (float*)(F.ws + WS_SCR) + (size_t)blockIdx.x * 65536, (bf16_t*)(F.ws + WS_MERGED)};
        pg8::gemm_phase<EpiMerge, SchedMerge>(ring, pg8::Dims{D, D, 512}, S, E);
    }
    SEAM(pb + 4);
    if (IN(pb + 5)) {
        SchedGrid S{lat_only ? 64 : NPAN, 8, F.G, cb, lat_only, (const char*)(F.ws + WS_MERGED), (const char*)(F.ws + WS_WOUT + (size_t)LAYER * 8 * MiB), (size_t)256 * D * 2, (size_t)256 * D * 2};
        EpiResid E{LAYER == 0 ? nullptr : (const float*)(F.ws + WS_X2), F.in[I_X], F.in[I_CTX], (float*)(F.ws + WS_X1), (const modacc_t*)(F.ws + WS_MOD) + (size_t)LAYER * 5 * ADA + 2 * D};
        pg8::gemm_phase<EpiResid, SchedGrid>(ring, pg8::Dims{D, D, D}, S, E);
    }
    SEAM(pb + 5);
}
__device__ __forceinline__ void layer0_ffn(Frame& F, const XcdBarrier& bar, const int lo, const int hi) {
    LAS unsigned char* ring = F.lds; const int cb = (int)blockIdx.x;
    if (IN(7)) phase_norm(F, (const float*)(F.ws + WS_X1), F.in[I_FNG], 0, 3, 4, false);
    SEAM(7);
    if (IN(8)) {
        SchedGrid S{NPAN, 44, F.G, cb, false, (const char*)(F.ws + WS_H), (const char*)(F.ws + WS_WGU0), (size_t)256 * D * 2, (size_t)256 * D * 2};
        EpiSwiglu E{(bf16_t*)(F.ws + WS_ACT)};
        pg8::gemm_phase<EpiSwiglu, SchedGrid>(ring, pg8::Dims{D, D, D}, S, E);
    }
    SEAM(8);
    if (IN(9)) {
        SchedGrid S{NPAN, 8, F.G, cb, false, (const char*)(F.ws + WS_ACT), (const char*)(F.ws + WS_WD0), (size_t)256 * DFF * 2, (size_t)256 * DFF * 2};
        EpiResid E{(const float*)(F.ws + WS_X1), nullptr, nullptr, (float*)(F.ws + WS_X2), (const modacc_t*)(F.ws + WS_MOD) + 5 * D};
        pg8::gemm_phase<EpiResid, SchedGrid>(ring, pg8::Dims{DFF, DFF, DFF}, S, E);
    }
    SEAM(9);
}

constexpr int N_PHASES = 21;
__global__ void __launch_bounds__(NTHREADS, 2) fwd(Args args) {
    extern __shared__ __attribute__((aligned(16))) unsigned char lds_raw[];
    Frame F;
    F.lds = (LAS unsigned char*)lds_raw; F.tid = threadIdx.x; F.lane = F.tid & 63; F.wave = __builtin_amdgcn_readfirstlane(F.tid >> 6);
    F.G = gridDim.x; F.gw = blockIdx.x * NWAVES + F.wave; F.NGW = F.G * NWAVES; F.ws = args.ws; F.ctl = (unsigned*)(args.ws + WS_CTL); F.in = args.in;
    volatile LAS unsigned* MISC = (volatile LAS unsigned*)(F.lds + MISC_OFF);
    if (F.tid < 64) MISC[F.tid] = 0u;
    __syncthreads();
    XcdBarrier bar; bar.bar = F.ctl + CW_BAR; bar.x = 0; bar.st = nullptr;
    const bool one_launch = (args.ph_hi - args.ph_lo) > 1;
    if (one_launch) bar = xcd_barrier_post(F.ctl + CW_BAR, MISC + 8);
    const int lo = args.ph_lo, hi = args.ph_hi;
    LAS unsigned char* ring = F.lds;
    const int cb = (int)blockIdx.x;
    float* X1 = (float*)(F.ws + WS_X1); bf16_t* ACT = (bf16_t*)(F.ws + WS_ACT);

    if (IN(0)) phase_prologue(F);
    SEAM(0);
    layer_common<0>(F, bar, lo, hi);
    layer0_ffn(F, bar, lo, hi);
    layer_common<1>(F, bar, lo, hi);
    if (IN(16)) phase_norm_router(F, X1);
    SEAM(16);
    if (IN(17)) phase_gather(F);
    SEAM(17);
    if (IN(18) || IN(19)) {
        int cntv[NEXP], off[NEXP + 1]; moe_offsets(F, cntv, off);
        if (IN(18)) {
            SchedMoe S; S.np = off[NEXP] >> 8; S.nN = 44; S.G = F.G; S.c = cb;
#pragma unroll
            for (int e = 0; e < NEXP; ++e) S.pend[e] = off[e + 1] >> 8;
            S.A = (const char*)(F.ws + WS_XS); S.W = (const char*)(F.ws + WS_WGUM); S.strideA = (size_t)256 * D * 2; S.strideB = (size_t)256 * D * 2; S.strideE = (size_t)44 * MiB;
            EpiSwiglu E{ACT};
            pg8::gemm_phase<EpiSwiglu, SchedMoe>(ring, pg8::Dims{D, D, D}, S, E);
        }
        SEAM(18);
        if (IN(19)) {
            SchedMoe S; S.np = off[NEXP] >> 8; S.nN = 8; S.G = F.G; S.c = cb;
#pragma unroll
            for (int e = 0; e < NEXP; ++e) S.pend[e] = off[e + 1] >> 8;
            S.A = (const char*)ACT; S.W = (const char*)(F.ws + WS_WDM); S.strideA = (size_t)256 * DFF * 2; S.strideB = (size_t)256 * DFF * 2; S.strideE = (size_t)22 * MiB;
            EpiBf16Plain E{(bf16_t*)(F.ws + WS_Y2), D};
            pg8::gemm_phase<EpiBf16Plain, SchedMoe>(ring, pg8::Dims{DFF, DFF, DFF}, S, E);
        }
    }
    SEAM(19);
    if (IN(20)) phase_final(F, X1, args.out);
#undef IN
#undef SEAM
}

extern "C" void kernel_launch(void* const* d_in, const int* in_sizes, int n_in, void* d_out, int out_size, void* d_ws, size_t ws_size, hipStream_t stream) {
    static int grid = 0;
    if (grid == 0) {
        if (n_in != 24 || out_size != NB * SEQ * D || ws_size < WS_END) { fprintf(stderr, "kernel_launch: unexpected shapes (n_in %d out %d ws %zu, need %zu)\n", n_in, out_size, ws_size, (size_t)WS_END); grid = -1; return; }
        int dev = 0, cus = 0, per_cu = 0;
        if (hipGetDevice(&dev) != hipSuccess || hipDeviceGetAttribute(&cus, hipDeviceAttributeMultiprocessorCount, dev) != hipSuccess) { grid = -1; return; }
        if (hipFuncSetAttribute((const void*)fwd, hipFuncAttributeMaxDynamicSharedMemorySize, LDS_BYTES) != hipSuccess) { fprintf(stderr, "kernel_launch: hipFuncSetAttribute failed\n"); grid = -1; return; }
        if (hipOccupancyMaxActiveBlocksPerMultiprocessor(&per_cu, (const void*)fwd, NTHREADS, LDS_BYTES) != hipSuccess || per_cu < 1) fprintf(stderr, "kernel_launch: occupancy query says %d\n", per_cu);
        (void)hipGetLastError();
        grid = cus;
    }
    if (grid < 0) return;
    if (hipMemsetAsync((char*)d_ws + WS_CTL, 0, CTL_ZERO_BYTES, stream) != hipSuccess) return;
    Args a{};
    for (int i = 0; i < 24; ++i) a.in[i] = (const float*)d_in[i];
    a.out = (float*)d_out; a.ws = (unsigned char*)d_ws;
#if MK_PER_PHASE
    for (int p = 0; p < N_PHASES; ++p) { a.ph_lo = p; a.ph_hi = p + 1; hipLaunchKernelGGL(fwd, dim3(grid), dim3(NTHREADS), LDS_BYTES, stream, a); }
#else
    a.ph_lo = 0; a.ph_hi = N_PHASES; hipLaunchKernelGGL(fwd, dim3(grid), dim3(NTHREADS), LDS_BYTES, stream, a);
#endif
    const hipError_t le = hipPeekAtLastError();
    if (le != hipSuccess) fprintf(stderr, "kernel_launch: launch failed: %s\n", hipGetErrorName(le));
}
```
